# Optimizing an MI355X kernel written in HIP

```python
import math
import jax, jax.numpy as jnp
from jax import lax
import numpy as np

D_MODEL = 1024
BATCH = 8
SEQ = 2048
DEPTH = 2
DEC_BATCH = 128
DEC_SEQ = 8
PAST_LEN = 16384
PAGE_SIZE = 128

N_AB = (DEPTH + 1) // 2
N_CD = DEPTH // 2
D_MIX = D_MODEL
EPS = 1e-6
GDN_HEADS = 4
GDN_DK = D_MODEL // 8
GDN_DV = D_MODEL // 8
GDN_CONV = 4
GDN_CHUNK = 64
D_A = GDN_HEADS * GDN_DV
D_QKV = GDN_HEADS * (2 * GDN_DK + GDN_DV)
SGU_CHUNK = 128
SGU_GROUPS = 4
D_B = D_MIX - D_A
SGU_GW = D_B // SGU_GROUPS
D_IN_AB = D_QKV + D_A + 2 * GDN_HEADS + 2 * D_B
AB_SPLITS = [D_QKV, D_QKV + D_A, D_QKV + D_A + GDN_HEADS, D_QKV + D_A + 2 * GDN_HEADS,
             D_QKV + D_A + 2 * GDN_HEADS + D_B]
POOL_WINDOWS = (2, 4, 8, 16)
POOL_GROUPS = len(POOL_WINDOWS)
D_C = D_MIX // 2
POOL_GW = D_C // POOL_GROUPS
POOL_BUF = max(POOL_WINDOWS) - 1
D_D = D_MIX - D_C
S5_GW = 16
S5_GROUPS = D_D // S5_GW
S5_STATE = 64
D_IN_CD = D_C + D_D
D_FF = 4 * D_MODEL
D_PLE = 256

kernel_name = 'hybrid_gdn_sgu_pool_s5_step'


def rmsnorm(x, g):
    xf = x.astype(jnp.float32)
    y = xf * lax.rsqrt(jnp.mean(xf * xf, axis=-1, keepdims=True) + EPS)
    return (y * g.astype(jnp.float32)).astype(x.dtype)


def layernorm(x, g, b):
    xf = x.astype(jnp.float32)
    xc = xf - jnp.mean(xf, axis=-1, keepdims=True)
    var = jnp.mean(xc * xc, axis=-1, keepdims=True)
    return (xc * lax.rsqrt(var + EPS) * g.astype(jnp.float32) + b.astype(jnp.float32)).astype(x.dtype)


def l2norm(x):
    return x * lax.rsqrt(jnp.sum(x * x, axis=-1, keepdims=True) + EPS)


def short_conv(x, buf, w):
    t = x.shape[1]
    xe = jnp.concatenate([buf.astype(x.dtype), x], axis=1)
    y = xe[:, 0:t] * w[0]
    for i in range(1, GDN_CONV):
        y = y + xe[:, i:i + t] * w[i]
    return y, xe[:, t:]


def gated_delta_rule(q, k, v, beta, g, s0):
    bsz, t, nh, dk = q.shape
    dv = v.shape[-1]
    c = min(GDN_CHUNK, t)
    n = -(-t // c)
    pad = n * c - t

    def prep(a):
        a = jnp.pad(a, [(0, 0), (0, pad)] + [(0, 0)] * (a.ndim - 2))
        a = a.reshape((bsz, n, c) + a.shape[2:])
        return jnp.moveaxis(a, 3, 1)

    q, k, v, beta, g = (prep(a) for a in (q, k, v, beta, g))
    gc = jnp.cumsum(g, axis=-1)
    tril = jnp.tril(jnp.ones((c, c), bool))
    strict = jnp.tril(jnp.ones((c, c), bool), -1)
    decay = jnp.exp(jnp.where(tril, gc[..., :, None] - gc[..., None, :], -jnp.inf))
    kk = jnp.einsum('bhnid,bhnjd->bhnij', k, k)
    lmat = jnp.where(strict, beta[..., :, None] * kk * decay, 0.0)
    eye = jnp.eye(c, dtype=jnp.float32)
    tinv = lax.linalg.triangular_solve(eye + lmat, jnp.broadcast_to(eye, lmat.shape),
                                       left_side=True, lower=True, unit_diagonal=True)
    u_base = jnp.einsum('bhnij,bhnje->bhnie', tinv, v * beta[..., None])
    w_dec = jnp.einsum('bhnij,bhnjd->bhnid', tinv, k * (beta * jnp.exp(gc))[..., None])
    qk = jnp.einsum('bhnid,bhnjd->bhnij', q, k) * decay
    g_last = gc[..., -1]
    k_tail = k * jnp.exp(g_last[..., None] - gc)[..., None]
    q_head = q * jnp.exp(gc)[..., None]

    def step(s, xs):
        q_h, qk_i, u_b, w_d, k_t, g_l = xs
        u = u_b - jnp.einsum('bhid,bhde->bhie', w_d, s)
        o = jnp.einsum('bhid,bhde->bhie', q_h, s) + jnp.einsum('bhij,bhje->bhie', qk_i, u)
        s = s * jnp.exp(g_l)[..., None, None] + jnp.einsum('bhid,bhie->bhde', k_t, u)
        return s, o

    xs = tuple(jnp.moveaxis(a, 2, 0) for a in (q_head, qk, u_base, w_dec, k_tail, g_last))
    s_fin, o = lax.scan(step, s0, xs)
    o = jnp.moveaxis(o, 0, 2).reshape(bsz, nh, n * c, dv)[:, :, :t]
    return jnp.transpose(o, (0, 2, 1, 3)), s_fin


def chunk_sgu(zu, zv, ln_g, ln_b, w_sp, b_sp):
    bsz, t, _ = zu.shape
    c = SGU_CHUNK
    u = jax.nn.gelu(zu)
    v = layernorm(jax.nn.gelu(zv), ln_g, ln_b)
    n = -(-t // c)
    pad = n * c - t
    vc = jnp.pad(v, ((0, 0), (0, pad), (0, 0))).reshape(bsz, n, c, SGU_GROUPS, SGU_GW)
    w = jnp.where(jnp.tril(jnp.ones((c, c), bool)), w_sp, 0.0)
    mixed = jnp.einsum('gts,bnsgc->bntgc', w, vc) + b_sp.T[None, None, :, :, None]
    mixed = mixed.reshape(bsz, n * c, D_B)[:, :t]
    start = ((t - 1) // c) * c
    return u * mixed.astype(u.dtype), v[:, start:]


def pool_mixer(x, buf, pos0, w_pool, scale):
    bsz, t, _ = x.shape
    xe = jnp.concatenate([buf.astype(x.dtype), x], axis=1)
    cs = jnp.pad(jnp.cumsum(xe.astype(jnp.float32), axis=1), ((0, 0), (1, 0), (0, 0)))
    pos = pos0 + jnp.arange(t)
    xf = x.astype(jnp.float32)
    e0 = POOL_BUF + 1
    outs = []
    for gi, win in enumerate(POOL_WINDOWS):
        lo, hi = gi * POOL_GW, (gi + 1) * POOL_GW
        s = cs[:, e0:e0 + t, lo:hi] - cs[:, e0 - win:e0 - win + t, lo:hi]
        cnt = jnp.minimum(win, pos + 1).astype(jnp.float32)[None, :, None]
        m = s / cnt - xf[:, :, lo:hi]
        outs.append(m @ w_pool[gi].astype(jnp.float32))
    y = jnp.concatenate(outs, axis=-1) * scale.astype(jnp.float32)
    return y.astype(x.dtype), xe[:, t:]


def s5_mixer(x, st_re, st_im, lam_re, lam_im, log_dt, b_re, b_im, c_re, c_im, d_skip, w_glu, b_glu):
    bsz, t, _ = x.shape
    f32 = jnp.float32
    u = x.astype(f32).reshape(bsz, t, S5_GROUPS, S5_GW)
    lam = lax.complex(lam_re.astype(f32), lam_im.astype(f32))
    dt = jnp.exp(log_dt.astype(f32))[:, None]
    lam_bar = jnp.exp(lam * dt)
    b_bar = ((lam_bar - 1.0) / lam)[..., None] * lax.complex(b_re.astype(f32), b_im.astype(f32))
    bu = jnp.einsum('gnc,btgc->btgn', b_bar, u.astype(jnp.complex64))
    s0 = lax.complex(st_re.astype(f32), st_im.astype(f32))
    bu = bu.at[:, 0].add(lam_bar * s0)
    a = jnp.broadcast_to(lam_bar, bu.shape)

    def comb(e1, e2):
        a1, b1 = e1
        a2, b2 = e2
        return a1 * a2, a2 * b1 + b2

    _, s = lax.associative_scan(comb, (a, bu), axis=1)
    cm = lax.complex(c_re.astype(f32), c_im.astype(f32))
    y = jnp.real(jnp.einsum('gcn,btgn->btgc', cm, s)) + d_skip.astype(f32).reshape(S5_GROUPS, S5_GW) * u
    y = jax.nn.gelu(y.reshape(bsz, t, D_D))
    y = y * jax.nn.sigmoid(y @ w_glu.astype(f32) + b_glu.astype(f32))
    s_last = s[:, -1]
    return y.astype(x.dtype), jnp.real(s_last), jnp.imag(s_last)


def layer_ab(h, conv_buf, s0, norm_mix, w_in, conv_w, a_log, dt_bias, norm_o,
             ln_g, ln_b, w_sp, b_sp, w_out):
    f32 = jnp.float32
    bsz, t, _ = h.shape
    z = rmsnorm(h, norm_mix) @ w_in
    qkv, zg, zb, za, zu, zv = jnp.split(z, AB_SPLITS, axis=-1)
    qkv, new_buf = short_conv(qkv, conv_buf, conv_w)
    qkv = jax.nn.silu(qkv).astype(f32)
    q, k, v = jnp.split(qkv, [GDN_HEADS * GDN_DK, 2 * GDN_HEADS * GDN_DK], axis=-1)
    q = l2norm(q.reshape(bsz, t, GDN_HEADS, GDN_DK)) * (GDN_DK ** -0.5)
    k = l2norm(k.reshape(bsz, t, GDN_HEADS, GDN_DK))
    v = v.reshape(bsz, t, GDN_HEADS, GDN_DV)
    beta = jax.nn.sigmoid(zb.astype(f32))
    g = -jnp.exp(a_log.astype(f32)) * jax.nn.softplus(za.astype(f32) + dt_bias.astype(f32))
    o, s_new = gated_delta_rule(q, k, v, beta, g, s0.astype(f32))
    o = rmsnorm(o, norm_o) * jax.nn.silu(zg.astype(f32).reshape(bsz, t, GDN_HEADS, GDN_DV))
    o_a = o.reshape(bsz, t, D_A).astype(h.dtype)
    o_b, v_rows = chunk_sgu(zu, zv, ln_g, ln_b, w_sp, b_sp)
    y = jnp.concatenate([o_a, o_b.astype(h.dtype)], axis=-1) @ w_out
    return h + y, new_buf, s_new, v_rows


def layer_cd(h, pool_buf, st_re, st_im, pos0, norm_mix, w_in, w_pool, pool_scale,
             lam_re, lam_im, log_dt, b_re, b_im, c_re, c_im, d_skip, w_glu, b_glu, w_out):
    z = rmsnorm(h, norm_mix) @ w_in
    xc, xd = jnp.split(z, [D_C], axis=-1)
    o_c, new_pool = pool_mixer(xc, pool_buf, pos0, w_pool, pool_scale)
    o_d, s_re, s_im = s5_mixer(xd, st_re, st_im, lam_re, lam_im, log_dt, b_re, b_im,
                               c_re, c_im, d_skip, w_glu, b_glu)
    y = jnp.concatenate([o_c, o_d], axis=-1) @ w_out
    return h + y, new_pool, s_re, s_im


def channel_mixer(h, norm_g, w_up, w_down):
    a = jax.nn.relu(rmsnorm(h, norm_g) @ w_up)
    return h + (a * a) @ w_down


def per_layer_embed(h, p, norm_g, w_proj, w_gate):
    gate = jax.nn.sigmoid(rmsnorm(h, norm_g) @ w_gate)
    return h + (p.astype(h.dtype) @ w_proj) * gate


def trunk(h, p, conv0, delta0, pool0, s5re0, s5im0, pos0, wt):
    convs, deltas, vrows, pools, s5res, s5ims = [], [], [], [], [], []
    for i in range(DEPTH):
        j = i // 2
        if i % 2 == 0:
            h, cb, sd, vr = layer_ab(h, conv0[j], delta0[j], wt['norm_mix'][i], wt['w_in_ab'][j],
                                     wt['conv_qkv'][j], wt['a_log'][j], wt['dt_bias'][j], wt['norm_o'][j],
                                     wt['ln_v_gain'][j], wt['ln_v_bias'][j], wt['w_spatial'][j],
                                     wt['b_spatial'][j], wt['w_out_ab'][j])
            convs.append(cb)
            deltas.append(sd)
            vrows.append(vr)
        else:
            h, pb, sre, sim = layer_cd(h, pool0[j], s5re0[j], s5im0[j], pos0, wt['norm_mix'][i],
                                       wt['w_in_cd'][j], wt['w_pool'][j], wt['pool_scale'][j],
                                       wt['lam_re'][j], wt['lam_im'][j], wt['log_dt'][j],
                                       wt['b_re'][j], wt['b_im'][j], wt['c_re'][j], wt['c_im'][j],
                                       wt['d_skip'][j], wt['w_glu'][j], wt['b_glu'][j], wt['w_out_cd'][j])
            pools.append(pb)
            s5res.append(sre)
            s5ims.append(sim)
        h = channel_mixer(h, wt['norm_ffn'][i], wt['w_ffn_up'][i], wt['w_ffn_down'][i])
        h = per_layer_embed(h, p[i], wt['norm_pe'][i], wt['w_pe_proj'][i], wt['w_pe_gate'][i])
    y = rmsnorm(h, wt['norm_final'])
    return (y, jnp.stack(convs), jnp.stack(deltas), jnp.stack(vrows),
            jnp.stack(pools), jnp.stack(s5res), jnp.stack(s5ims))


def setup_inputs(seed: int = 0) -> dict:
    key = jax.random.key(seed)
    ks = iter(jax.random.split(key, 64))
    f32 = jnp.float32

    def nrm(shape, s=1.0):
        return jax.random.normal(next(ks), shape, f32) * s

    def gain(shape):
        return 1.0 + nrm(shape, 0.02)

    def unif(shape, lo, hi):
        return jax.random.uniform(next(ks), shape, f32, minval=lo, maxval=hi)

    dt_a = unif((N_AB, GDN_HEADS), 1e-3, 1e-1)
    inp = {
        'x_prompt': nrm((BATCH, SEQ, D_MODEL)),
        'x_sample': nrm((DEC_BATCH, DEC_SEQ, D_MODEL)),
        'state_conv': nrm((N_AB, DEC_BATCH, GDN_CONV - 1, D_QKV)),
        'state_delta': nrm((N_AB, DEC_BATCH, GDN_HEADS, GDN_DK, GDN_DV), GDN_DK ** -0.5),
        'state_pool': nrm((N_CD, DEC_BATCH, POOL_BUF, D_C)),
        'state_s5_re': nrm((N_CD, DEC_BATCH, S5_GROUPS, S5_STATE), 0.1),
        'state_s5_im': nrm((N_CD, DEC_BATCH, S5_GROUPS, S5_STATE), 0.1),
        'p_prompt': nrm((DEPTH, BATCH, SEQ, D_PLE)),
        'p_sample': nrm((DEPTH, DEC_BATCH, DEC_SEQ, D_PLE)),
        'norm_mix': gain((DEPTH, D_MODEL)),
        'norm_ffn': gain((DEPTH, D_MODEL)),
        'norm_pe': gain((DEPTH, D_MODEL)),
        'norm_final': gain((D_MODEL,)),
        'w_in_ab': nrm((N_AB, D_MODEL, D_IN_AB), D_MODEL ** -0.5),
        'conv_qkv': nrm((N_AB, GDN_CONV, D_QKV), GDN_CONV ** -0.5),
        'a_log': jnp.log(unif((N_AB, GDN_HEADS), 1.0, 16.0)),
        'dt_bias': jnp.log(jnp.expm1(dt_a)),
        'norm_o': gain((N_AB, GDN_DV)),
        'ln_v_gain': gain((N_AB, D_B)),
        'ln_v_bias': nrm((N_AB, D_B), 0.02),
        'w_spatial': nrm((N_AB, SGU_GROUPS, SGU_CHUNK, SGU_CHUNK), SGU_CHUNK ** -0.5),
        'b_spatial': 1.0 + nrm((N_AB, SGU_GROUPS, SGU_CHUNK), 0.1),
        'w_out_ab': nrm((N_AB, D_A + D_B, D_MODEL), (D_A + D_B) ** -0.5),
        'w_in_cd': nrm((N_CD, D_MODEL, D_IN_CD), D_MODEL ** -0.5),
        'w_pool': nrm((N_CD, POOL_GROUPS, POOL_GW, POOL_GW), POOL_GW ** -0.5),
        'pool_scale': gain((N_CD, D_C)),
        'lam_re': -0.5 + nrm((N_CD, S5_GROUPS, S5_STATE), 0.01),
        'lam_im': math.pi * jnp.arange(S5_STATE, dtype=f32) + nrm((N_CD, S5_GROUPS, S5_STATE), 0.01),
        'log_dt': unif((N_CD, S5_GROUPS), math.log(1e-3), math.log(1e-1)),
        'b_re': nrm((N_CD, S5_GROUPS, S5_STATE, S5_GW), S5_GW ** -0.5),
        'b_im': nrm((N_CD, S5_GROUPS, S5_STATE, S5_GW), S5_GW ** -0.5),
        'c_re': nrm((N_CD, S5_GROUPS, S5_GW, S5_STATE), S5_STATE ** -0.5),
        'c_im': nrm((N_CD, S5_GROUPS, S5_GW, S5_STATE), S5_STATE ** -0.5),
        'd_skip': nrm((N_CD, D_D)),
        'w_glu': nrm((N_CD, D_D, D_D), D_D ** -0.5),
        'b_glu': nrm((N_CD, D_D), 0.01),
        'w_out_cd': nrm((N_CD, D_C + D_D, D_MODEL), (D_C + D_D) ** -0.5),
        'w_ffn_up': nrm((DEPTH, D_MODEL, D_FF), D_MODEL ** -0.5),
        'w_ffn_down': nrm((DEPTH, D_FF, D_MODEL), D_FF ** -0.5),
        'w_pe_proj': nrm((DEPTH, D_PLE, D_MODEL), D_PLE ** -0.5),
        'w_pe_gate': nrm((DEPTH, D_MODEL, D_MODEL), D_MODEL ** -0.5),
    }
    return inp


def reference(x_prompt, x_sample, state_conv, state_delta, state_pool, state_s5_re, state_s5_im,
              p_prompt, p_sample, norm_mix, norm_ffn, norm_pe, norm_final, w_in_ab, conv_qkv,
              a_log, dt_bias, norm_o, ln_v_gain, ln_v_bias, w_spatial, b_spatial, w_out_ab,
              w_in_cd, w_pool, pool_scale, lam_re, lam_im, log_dt, b_re, b_im, c_re, c_im,
              d_skip, w_glu, b_glu, w_out_cd, w_ffn_up, w_ffn_down, w_pe_proj, w_pe_gate):
    wt = {'norm_mix': norm_mix, 'norm_ffn': norm_ffn, 'norm_pe': norm_pe, 'norm_final': norm_final,
          'w_in_ab': w_in_ab, 'conv_qkv': conv_qkv, 'a_log': a_log, 'dt_bias': dt_bias,
          'norm_o': norm_o, 'ln_v_gain': ln_v_gain, 'ln_v_bias': ln_v_bias, 'w_spatial': w_spatial,
          'b_spatial': b_spatial, 'w_out_ab': w_out_ab, 'w_in_cd': w_in_cd, 'w_pool': w_pool,
          'pool_scale': pool_scale, 'lam_re': lam_re, 'lam_im': lam_im, 'log_dt': log_dt,
          'b_re': b_re, 'b_im': b_im, 'c_re': c_re, 'c_im': c_im, 'd_skip': d_skip,
          'w_glu': w_glu, 'b_glu': b_glu, 'w_out_cd': w_out_cd, 'w_ffn_up': w_ffn_up,
          'w_ffn_down': w_ffn_down, 'w_pe_proj': w_pe_proj, 'w_pe_gate': w_pe_gate}
    bp = x_prompt.shape[0]
    z_conv = jnp.zeros((N_AB, bp) + state_conv.shape[2:], x_prompt.dtype)
    z_delta = jnp.zeros((N_AB, bp) + state_delta.shape[2:], jnp.float32)
    z_pool = jnp.zeros((N_CD, bp) + state_pool.shape[2:], x_prompt.dtype)
    z_s5 = jnp.zeros((N_CD, bp) + state_s5_re.shape[2:], jnp.float32)
    y_prompt, conv_p, delta_p, sgu_v_p, pool_p, s5re_p, s5im_p = trunk(
        x_prompt, p_prompt, z_conv, z_delta, z_pool, z_s5, z_s5, 0, wt)
    y_sample, conv_s, delta_s, sgu_v_s, pool_s, s5re_s, s5im_s = trunk(
        x_sample, p_sample, state_conv, state_delta, state_pool, state_s5_re, state_s5_im, PAST_LEN, wt)
    return (y_prompt, y_sample, conv_p, delta_p, sgu_v_p, pool_p, s5re_p, s5im_p,
            conv_s, delta_s, sgu_v_s, pool_s, s5re_s, s5im_s)
```

```cpp
#include <hip/hip_runtime.h>
#include <hip/hip_cooperative_groups.h>
#include <cstdio>
namespace cg = cooperative_groups;

__device__ __forceinline__ int lane_id_() { return (int)__builtin_amdgcn_mbcnt_hi(~0u, __builtin_amdgcn_mbcnt_lo(~0u, 0u)); }
__device__ __forceinline__ int opaque_tid(int wv) { int t; asm volatile("v_mbcnt_lo_u32_b32 %0, -1, 0\n\tv_mbcnt_hi_u32_b32 %0, -1, %0\n\tv_lshl_add_u32 %0, %1, 6, %0" : "=&v"(t) : "s"(wv)); return t; }
namespace pg8 {
#define PG8_LAS __attribute__((address_space(3)))
typedef unsigned short bf16_t;
typedef short bf16x8 __attribute__((ext_vector_type(8)));
typedef float f32x4 __attribute__((ext_vector_type(4)));
typedef unsigned u32x4 __attribute__((ext_vector_type(4)));
typedef unsigned u32x2 __attribute__((ext_vector_type(2)));
constexpr int BM = 256, BK = 64, HALF = 128, HTB = HALF * BK * 2, STAGE_BYTES = 8 * HTB, NXCD = 8, WGM = 8;

__host__ __device__ __forceinline__ int lds_byte(int r, int c) { const int st = (r >> 4) * 2 + (c >> 5), rr = r & 15, cc = c & 31, ob = rr * 64 + cc * 2; return st * 1024 + (ob ^ (((ob >> 9) & 1) << 5)); }
__host__ __device__ __forceinline__ void stage_rc(int b, int& R, int& C) { const int st = b / 1024, sb = b % 1024, swz = sb ^ (((sb >> 9) & 1) << 5); R = (st >> 1) * 16 + swz / 64; C = (st & 1) * 32 + (swz % 64) / 2; }

struct Unit { int pm, pn; };
struct Gemm { const bf16_t* A; const bf16_t* Bt; int M, N, K; };

struct StaticOrder {
    int nM, nN, nwg, G, c;
    __host__ __device__ void init(int M, int N, int G_, int c_) { nM = M / BM; nN = N / BM; nwg = nM * nN; G = G_; c = c_; }
    __host__ __device__ bool next(int i, Unit& u) const {
        const long L = (long)i * G + c; if (L >= nwg) return false;
        int wgid = (int)L; { const int q = nwg / NXCD, r = nwg % NXCD, xcd = wgid % NXCD, off = wgid / NXCD; wgid = (xcd < r ? xcd * (q + 1) : r * (q + 1) + (xcd - r) * q) + off; }
        const int nig = WGM * nN, gid = wgid / nig, fm = gid * WGM, gsz = (nM - fm) < WGM ? (nM - fm) : WGM;
        u.pm = fm + ((wgid % nig) % gsz); u.pn = (wgid % nig) / gsz; return true;
    }
};

template <class Epi, class Sched>
__device__ __forceinline__ void gemm_phase(int wv, PG8_LAS unsigned char* lds, const Gemm g, const Sched& S, const Epi& E) {
    const int tid = opaque_tid(wv), wid = __builtin_amdgcn_readfirstlane(tid >> 6), lane = tid & 63, wr = wid >> 2, wc = wid & 3, fr = lane & 15, fq = lane >> 4;
    const int K = g.K, nt = K / BK;
    unsigned voffA[2], voffB[2];
#pragma unroll
    for (int i = 0; i < 2; ++i) { int R, C; stage_rc(tid * 16 + i * 8192, R, C); voffA[i] = (unsigned)(R * K + C) * 2u; voffB[i] = (unsigned)(R * K + C) * 2u; }
    const size_t kstep = (size_t)(BK * 2);
    const size_t hstep = (size_t)HALF * K * 2;
    const size_t tstep = 2 * hstep;
    const unsigned ldsw = (unsigned)wid * 1024u;
    const int aoff = lds_byte(wr * 64 + fr, fq * 8), boff = lds_byte(wc * 32 + fr, fq * 8);
#define PG8_SA(b, h) (((b) * 2 + (h)) * HTB)
#define PG8_SB(b, h) ((4 + (b) * 2 + (h)) * HTB)
#define PG8_STAGE(bufoff, gbase, voff) do { _Pragma("unroll") for (int _i = 0; _i < 2; ++_i) \
        __builtin_amdgcn_global_load_lds((const unsigned*)((const char*)(gbase) + (voff)[_i]), (PG8_LAS unsigned*)(lds + (bufoff) + ldsw + _i * 8192), 16, 0, 0); } while (0)
#define PG8_LDA(dst, b, h) do { _Pragma("unroll") for (int m = 0; m < 4; ++m) _Pragma("unroll") for (int k = 0; k < 2; ++k) dst[m][k] = *(const PG8_LAS bf16x8*)(lds + PG8_SA(b, h) + aoff + m * 2048 + k * 1024); } while (0)
#define PG8_LDB(dst, b, h) do { _Pragma("unroll") for (int n = 0; n < 2; ++n) _Pragma("unroll") for (int k = 0; k < 2; ++k) dst[n][k] = *(const PG8_LAS bf16x8*)(lds + PG8_SB(b, h) + boff + n * 2048 + k * 1024); } while (0)
#define PG8_MMA(ai, bj, At, Bt) do { __builtin_amdgcn_s_setprio(1); _Pragma("unroll") for (int m = 0; m < 4; ++m) _Pragma("unroll") for (int n = 0; n < 2; ++n) _Pragma("unroll") for (int k = 0; k < 2; ++k) \
        acc[ai][bj][m][n] = __builtin_amdgcn_mfma_f32_16x16x32_bf16(Bt[n][k], At[m][k], acc[ai][bj][m][n], 0, 0, 0); __builtin_amdgcn_s_setprio(0); } while (0)
#define PG8_WAIT_V(n) asm volatile("s_waitcnt vmcnt(" #n ")" ::: "memory")
#define PG8_WAIT_L(n) asm volatile("s_waitcnt lgkmcnt(" #n ")" ::: "memory")
#define PG8_BAR __builtin_amdgcn_s_barrier()
#define PG8_SCHED __builtin_amdgcn_sched_barrier(0)
    Unit cur, nxt; int ui = 0;
    if (!S.next(0, cur)) return;
    f32x4 acc[2][2][4][2];
#pragma unroll
    for (int a = 0; a < 2; ++a)
#pragma unroll
        for (int b = 0; b < 2; ++b)
#pragma unroll
            for (int m = 0; m < 4; ++m)
#pragma unroll
                for (int n = 0; n < 2; ++n) acc[a][b][m][n] = (f32x4){0.f, 0.f, 0.f, 0.f};
    bf16x8 At[4][2], B0[2][2], B1[2][2];
    const char* cA = (const char*)g.A + (size_t)cur.pm * tstep; const char* cB = (const char*)g.Bt + (size_t)cur.pn * tstep;
    PG8_STAGE(PG8_SB(0, 0), cB, voffB); PG8_STAGE(PG8_SA(0, 0), cA, voffA); PG8_STAGE(PG8_SB(0, 1), cB + hstep, voffB); PG8_STAGE(PG8_SA(0, 1), cA + hstep, voffA);
    if (wr == 1) PG8_BAR;
    PG8_WAIT_V(4); PG8_BAR;
    PG8_STAGE(PG8_SB(1, 0), cB + kstep, voffB); PG8_STAGE(PG8_SA(1, 0), cA + kstep, voffA); PG8_STAGE(PG8_SB(1, 1), cB + hstep + kstep, voffB);
    PG8_WAIT_V(6); PG8_BAR;
    for (;;) {
        const bool has_next = S.next(ui + 1, nxt);
        const char* nA = has_next ? (const char*)g.A + (size_t)nxt.pm * tstep : cA; const char* nB = has_next ? (const char*)g.Bt + (size_t)nxt.pn * tstep : cB;
        for (int t = 0; t < nt; t += 2) {
            const bool last = (t == nt - 2);
            const char* a1 = cA + (size_t)(t + 1) * kstep;
            const char* a2 = last ? nA : cA + (size_t)(t + 2) * kstep; const char* b2 = last ? nB : cB + (size_t)(t + 2) * kstep;
            const char* a3 = a2 + kstep; const char* b3 = b2 + kstep;
            PG8_LDB(B0, 0, 0); PG8_SCHED; PG8_LDA(At, 0, 0); PG8_STAGE(PG8_SA(1, 1), a1 + hstep, voffA);
            PG8_WAIT_L(8); PG8_BAR; PG8_WAIT_L(0); PG8_MMA(0, 0, At, B0); PG8_BAR; PG8_SCHED;
            PG8_LDB(B1, 0, 1); PG8_STAGE(PG8_SB(0, 0), b2, voffB);
            PG8_BAR; PG8_WAIT_L(0); PG8_MMA(0, 1, At, B1); PG8_BAR;
            PG8_LDA(At, 0, 1); PG8_STAGE(PG8_SA(0, 0), a2, voffA);
            PG8_BAR; PG8_WAIT_L(0); PG8_MMA(1, 0, At, B0); PG8_BAR; PG8_SCHED;
            PG8_STAGE(PG8_SB(0, 1), b2 + hstep, voffB);
            PG8_WAIT_V(6); PG8_BAR; PG8_MMA(1, 1, At, B1); PG8_BAR;
            PG8_LDB(B0, 1, 0); PG8_SCHED; PG8_LDA(At, 1, 0); PG8_STAGE(PG8_SA(0, 1), a2 + hstep, voffA);
            PG8_WAIT_L(8); PG8_BAR; PG8_WAIT_L(0); PG8_MMA(0, 0, At, B0); PG8_BAR; PG8_SCHED;
            PG8_LDB(B1, 1, 1); PG8_STAGE(PG8_SB(1, 0), b3, voffB);
            PG8_BAR; PG8_WAIT_L(0); PG8_MMA(0, 1, At, B1); PG8_BAR;
            PG8_LDA(At, 1, 1); PG8_STAGE(PG8_SA(1, 0), a3, voffA);
            PG8_BAR; PG8_WAIT_L(0); PG8_MMA(1, 0, At, B0); PG8_BAR; PG8_SCHED;
            PG8_STAGE(PG8_SB(1, 1), b3 + hstep, voffB);
            PG8_WAIT_V(6); PG8_BAR; PG8_MMA(1, 1, At, B1); PG8_BAR;
        }
        E(acc, cur, wr, wc, fr, fq);
        if (!has_next) break;
#pragma unroll
        for (int a = 0; a < 2; ++a)
#pragma unroll
            for (int b = 0; b < 2; ++b)
#pragma unroll
                for (int m = 0; m < 4; ++m)
#pragma unroll
                    for (int n = 0; n < 2; ++n) acc[a][b][m][n] = (f32x4){0.f, 0.f, 0.f, 0.f};
        cur = nxt; cA = nA; cB = nB; ++ui;
    }
    PG8_WAIT_V(0);
    if (wr == 0) PG8_BAR;
    PG8_BAR;
#undef PG8_SA
#undef PG8_SB
#undef PG8_STAGE
#undef PG8_LDA
#undef PG8_LDB
#undef PG8_MMA
#undef PG8_WAIT_V
#undef PG8_WAIT_L
#undef PG8_BAR
#undef PG8_SCHED
}
}

using pg8::bf16_t; using pg8::bf16x8; using pg8::f32x4; using pg8::u32x2; using pg8::u32x4; using pg8::Unit;

constexpr int MROWS = 17408, MP = 16384, DM = 1024, LDZ = 3328, DFF = 4096, NIN = 41;
constexpr float EPSF = 1e-6f;
constexpr int LDS_BYTES = 135168;

constexpr size_t WS_BIG = 0;
constexpr size_t BIG_BYTES = (size_t)MROWS * DFF * 2;
constexpr size_t WS_WB = WS_BIG + BIG_BYTES;
constexpr size_t WO_IN_AB = 0;
constexpr size_t WO_OUT_AB = WO_IN_AB + (size_t)LDZ * 1024;
constexpr size_t WO_UP0 = WO_OUT_AB + (size_t)1024 * 1024;
constexpr size_t WO_DOWN0 = WO_UP0 + (size_t)4096 * 1024;
constexpr size_t WO_GATE0 = WO_DOWN0 + (size_t)4096 * 1024;
constexpr size_t WO_PROJ0 = WO_GATE0 + (size_t)1024 * 1024;
constexpr size_t WO_IN_CD = WO_PROJ0 + (size_t)1024 * 256;
constexpr size_t WO_GLU = WO_IN_CD + (size_t)1024 * 1024;
constexpr size_t WO_OUT_CD = WO_GLU + (size_t)512 * 512;
constexpr size_t WO_UP1 = WO_OUT_CD + (size_t)1024 * 1024;
constexpr size_t WO_DOWN1 = WO_UP1 + (size_t)4096 * 1024;
constexpr size_t WO_GATE1 = WO_DOWN1 + (size_t)4096 * 1024;
constexpr size_t WO_PROJ1 = WO_GATE1 + (size_t)1024 * 1024;
constexpr size_t WB_ELEMS = WO_PROJ1 + (size_t)1024 * 256;
constexpr size_t WS_X = WS_WB + WB_ELEMS * 2;
constexpr size_t ABUF_BYTES = (size_t)MROWS * DM * 2;
constexpr size_t WS_Y = WS_X + ABUF_BYTES;
constexpr size_t WS_SS = WS_Y + ABUF_BYTES;
constexpr size_t WS_END = WS_SS + (size_t)7 * MROWS * 4;
static_assert(WS_END <= (size_t)268435456, "workspace over 256 MiB");
constexpr size_t BIG_Z1 = 0;
constexpr size_t BIG_YG = (size_t)MROWS * DM * 4;

constexpr size_t O_Y = 0;
constexpr size_t O_CONV_P = (size_t)MROWS * DM;
constexpr size_t O_DELTA_P = O_CONV_P + 8 * 3 * 1536;
constexpr size_t O_SGUV_P = O_DELTA_P + (size_t)8 * 4 * 128 * 128;
constexpr size_t O_POOL_P = O_SGUV_P + (size_t)8 * 128 * 512;
constexpr size_t O_S5RE_P = O_POOL_P + (size_t)8 * 15 * 512;
constexpr size_t O_S5IM_P = O_S5RE_P + (size_t)8 * 32 * 64;
constexpr size_t O_CONV_S = O_S5IM_P + (size_t)8 * 32 * 64;
constexpr size_t O_DELTA_S = O_CONV_S + (size_t)128 * 3 * 1536;
constexpr size_t O_SGUV_S = O_DELTA_S + (size_t)128 * 4 * 128 * 128;
constexpr size_t O_POOL_S = O_SGUV_S + (size_t)128 * 8 * 512;
constexpr size_t O_S5RE_S = O_POOL_S + (size_t)128 * 15 * 512;
constexpr size_t O_S5IM_S = O_S5RE_S + (size_t)128 * 32 * 64;
constexpr size_t O_END = O_S5IM_S + (size_t)128 * 32 * 64;

enum { I_XP = 0, I_XS, I_SCONV, I_SDELTA, I_SPOOL, I_S5RE, I_S5IM, I_PP, I_PS, I_NMIX, I_NFFN, I_NPE, I_NFINAL, I_WINAB, I_CONVW, I_ALOG, I_DTB, I_NORMO, I_LNG, I_LNB,
       I_WSP, I_BSP, I_WOUTAB, I_WINCD, I_WPOOL, I_PSCALE, I_LAMRE, I_LAMIM, I_LOGDT, I_BRE, I_BIM, I_CRE, I_CIM, I_DSKIP, I_WGLU, I_BGLU, I_WOUTCD, I_WUP, I_WDOWN, I_WPROJ, I_WGATE };

struct Params { const float* in[NIN]; float* out; unsigned char* ws; };

__device__ __forceinline__ float bf2f(bf16_t v) { return __uint_as_float(((unsigned)v) << 16); }
__device__ __forceinline__ unsigned pk2(float lo, float hi) { unsigned r; asm volatile("v_cvt_pk_bf16_f32 %0, %1, %2" : "=v"(r) : "v"(lo), "v"(hi)); return r; }
__device__ __forceinline__ bf16_t f2bf(float f) { return (bf16_t)(pk2(f, 0.f) & 0xffffu); }
__device__ __forceinline__ float sigmoidf_(float x) { return 1.0f / (1.0f + __expf(-x)); }
__device__ __forceinline__ float siluf_(float x) { return x / (1.0f + __expf(-x)); }
__device__ __forceinline__ float geluf_(float x) { const float y = 1.5957691216f * (x + 0.044715f * x * x * x); return x / (1.0f + __expf(-y)); }
template <int CTRL> __device__ __forceinline__ float dpp_f(float x) { return __builtin_bit_cast(float, __builtin_amdgcn_mov_dpp(__builtin_bit_cast(int, x), CTRL, 0xf, 0xf, true)); }
__device__ __forceinline__ float row16_sum(float v) { v += dpp_f<0xB1>(v); v += dpp_f<0x4E>(v); v += dpp_f<0x141>(v); v += dpp_f<0x140>(v); return v; }
__device__ __forceinline__ float rdlane(float v, int l) { return __builtin_bit_cast(float, __builtin_amdgcn_readlane(__builtin_bit_cast(int, v), l)); }
__device__ __forceinline__ float wave_sum(float v) { v = row16_sum(v); return (rdlane(v, 0) + rdlane(v, 16)) + (rdlane(v, 32) + rdlane(v, 48)); }
__device__ __forceinline__ float shfl_xor_l(float v, int lane, int m) { return __builtin_bit_cast(float, __builtin_amdgcn_ds_bpermute((lane ^ m) << 2, __builtin_bit_cast(int, v))); }
__device__ __forceinline__ float rstd_of(const float* ss, int row) { return rsqrtf(ss[row] * (1.0f / 1024.0f) + EPSF); }

#define EPI_LOOP_ROWS for (int ai = 0; ai < 2; ++ai) for (int m = 0; m < 4; ++m)
#define EPI_LOOP_COLS for (int bj = 0; bj < 2; ++bj) for (int n = 0; n < 2; ++n)

struct EpiZ {
    bf16_t* Z; int ldz; const float* ss;
    __device__ __forceinline__ void operator()(const f32x4 (&acc)[2][2][4][2], const Unit& u, int wr, int wc, int fr, int fq) const {
        const int row0 = u.pm * 256 + wr * 64 + fr, col0 = u.pn * 256 + wc * 32 + 4 * fq;
#pragma unroll
        EPI_LOOP_ROWS { const int row = row0 + ai * 128 + m * 16; const float rs = rstd_of(ss, row); bf16_t* rp = Z + (size_t)row * ldz + col0;
#pragma unroll
            EPI_LOOP_COLS { const f32x4 v = acc[ai][bj][m][n] * rs; u32x2 w; w.x = pk2(v[0], v[1]); w.y = pk2(v[2], v[3]); *(u32x2*)(rp + bj * 128 + n * 16) = w; } }
    }
};
struct EpiZ1 {
    float* Z; const float* ss;
    __device__ __forceinline__ void operator()(const f32x4 (&acc)[2][2][4][2], const Unit& u, int wr, int wc, int fr, int fq) const {
        const int row0 = u.pm * 256 + wr * 64 + fr, col0 = u.pn * 256 + wc * 32 + 4 * fq;
#pragma unroll
        EPI_LOOP_ROWS { const int row = row0 + ai * 128 + m * 16; const float rs = rstd_of(ss, row); float* rp = Z + (size_t)row * 1024 + col0;
#pragma unroll
            EPI_LOOP_COLS { *(f32x4*)(rp + bj * 128 + n * 16) = acc[ai][bj][m][n] * rs; } }
    }
};
struct EpiUp {
    bf16_t* Hd; const float* ss;
    __device__ __forceinline__ void operator()(const f32x4 (&acc)[2][2][4][2], const Unit& u, int wr, int wc, int fr, int fq) const {
        const int row0 = u.pm * 256 + wr * 64 + fr, col0 = u.pn * 256 + wc * 32 + 4 * fq;
#pragma unroll
        EPI_LOOP_ROWS { const int row = row0 + ai * 128 + m * 16; const float rs = rstd_of(ss, row); bf16_t* rp = Hd + (size_t)row * DFF + col0;
#pragma unroll
            EPI_LOOP_COLS { f32x4 v = acc[ai][bj][m][n] * rs;
#pragma unroll
                for (int j = 0; j < 4; ++j) { const float r = fmaxf(v[j], 0.f); v[j] = r * r; }
                u32x2 w; w.x = pk2(v[0], v[1]); w.y = pk2(v[2], v[3]); *(u32x2*)(rp + bj * 128 + n * 16) = w; } }
    }
};
struct EpiRes {
    const float* resP; const float* resS; float* H; bf16_t* HB; float* ssout;
    __device__ __forceinline__ void operator()(const f32x4 (&acc)[2][2][4][2], const Unit& u, int wr, int wc, int fr, int fq) const {
        const int row0 = u.pm * 256 + wr * 64 + fr, col0 = u.pn * 256 + wc * 32 + 4 * fq;
#pragma unroll
        EPI_LOOP_ROWS { const int row = row0 + ai * 128 + m * 16;
            const float* rr = (row < MP ? resP + (size_t)row * 1024 : resS + (size_t)(row - MP) * 1024) + col0;
            float* hp = H + (size_t)row * 1024 + col0; bf16_t* bp = HB + (size_t)row * 1024 + col0; float s = 0.f;
#pragma unroll
            EPI_LOOP_COLS { const int co = bj * 128 + n * 16; const f32x4 v = *(const f32x4*)(rr + co) + acc[ai][bj][m][n];
                *(f32x4*)(hp + co) = v; u32x2 w; w.x = pk2(v[0], v[1]); w.y = pk2(v[2], v[3]); *(u32x2*)(bp + co) = w;
                s += (v[0] * v[0] + v[1] * v[1]) + (v[2] * v[2] + v[3] * v[3]); }
            s += shfl_xor_l(s, fq * 16 + fr, 16); s += shfl_xor_l(s, fq * 16 + fr, 32);
            if (fq == 0) atomicAdd(ssout + row, s); }
    }
};
struct EpiGate {
    f32x4* St; const float* ss;
    __device__ __forceinline__ void operator()(const f32x4 (&acc)[2][2][4][2], const Unit& u, int wr, int wc, int fr, int fq) const {
        const int row0 = u.pm * 256 + wr * 64 + fr; const size_t ub = ((size_t)(u.pm * 4 + u.pn) * 32) * 512 + (wr * 4 + wc) * 64 + fq * 16 + fr;
#pragma unroll
        EPI_LOOP_ROWS { const int row = row0 + ai * 128 + m * 16; const float rs = rstd_of(ss, row);
#pragma unroll
            EPI_LOOP_COLS { f32x4 v = acc[ai][bj][m][n] * rs;
#pragma unroll
                for (int j = 0; j < 4; ++j) v[j] = sigmoidf_(v[j]);
                St[ub + (size_t)(((ai * 2 + bj) * 4 + m) * 2 + n) * 512] = v; } }
    }
};
struct EpiProj {
    const f32x4* St; float* H; bf16_t* HB; float* ssout;
    __device__ __forceinline__ void operator()(const f32x4 (&acc)[2][2][4][2], const Unit& u, int wr, int wc, int fr, int fq) const {
        const int row0 = u.pm * 256 + wr * 64 + fr, col0 = u.pn * 256 + wc * 32 + 4 * fq; const size_t ub = ((size_t)(u.pm * 4 + u.pn) * 32) * 512 + (wr * 4 + wc) * 64 + fq * 16 + fr;
#pragma unroll
        EPI_LOOP_ROWS { const int row = row0 + ai * 128 + m * 16;
            float* hp = H + (size_t)row * 1024 + col0; bf16_t* bp = HB + (size_t)row * 1024 + col0; float s = 0.f;
#pragma unroll
            EPI_LOOP_COLS { const int co = bj * 128 + n * 16; const f32x4 g = St[ub + (size_t)(((ai * 2 + bj) * 4 + m) * 2 + n) * 512];
                const f32x4 v = *(const f32x4*)(hp + co) + acc[ai][bj][m][n] * g;
                *(f32x4*)(hp + co) = v; u32x2 w; w.x = pk2(v[0], v[1]); w.y = pk2(v[2], v[3]); *(u32x2*)(bp + co) = w;
                s += (v[0] * v[0] + v[1] * v[1]) + (v[2] * v[2] + v[3] * v[3]); }
            s += shfl_xor_l(s, fq * 16 + fr, 16); s += shfl_xor_l(s, fq * 16 + fr, 32);
            if (fq == 0) atomicAdd(ssout + row, s); }
    }
};
struct EpiGlu {
    const bf16_t* YG; const float* bg; bf16_t* Mix;
    __device__ __forceinline__ void operator()(const f32x4 (&acc)[2][2][4][2], const Unit& u, int wr, int wc, int fr, int fq) const {
        const int row0 = u.pm * 256 + wr * 64 + fr, col0 = u.pn * 256 + wc * 32 + 4 * fq;
#pragma unroll
        EPI_LOOP_ROWS { const int row = row0 + ai * 128 + m * 16;
#pragma unroll
            EPI_LOOP_COLS { const int col = col0 + bj * 128 + n * 16; const u32x2 yv = *(const u32x2*)(YG + (size_t)row * 512 + col); const f32x4 b = *(const f32x4*)(bg + col);
                const f32x4 a = acc[ai][bj][m][n] + b; f32x4 y; y[0] = __uint_as_float(yv.x << 16); y[1] = __uint_as_float(yv.x & 0xffff0000u); y[2] = __uint_as_float(yv.y << 16); y[3] = __uint_as_float(yv.y & 0xffff0000u);
                f32x4 v;
#pragma unroll
                for (int j = 0; j < 4; ++j) v[j] = y[j] * sigmoidf_(a[j]);
                u32x2 w; w.x = pk2(v[0], v[1]); w.y = pk2(v[2], v[3]); *(u32x2*)(Mix + (size_t)row * 1024 + 512 + col) = w; } }
    }
};

template <class Epi>
__device__ __forceinline__ void run_gemm(int wv, PG8_LAS unsigned char* lds, const bf16_t* A, const bf16_t* Bt, int M, int N, int K, const Epi& E) {
    pg8::StaticOrder S; S.init(M, N, (int)gridDim.x, (int)blockIdx.x);
    pg8::Gemm g{A, Bt, M, N, K};
    pg8::gemm_phase<Epi, pg8::StaticOrder>(wv, lds, g, S, E);
}

struct SrcPlain { const float* W; const float* g; int N;
    __device__ __forceinline__ float operator()(int k, int n) const { const float w = W[(size_t)k * N + n]; return g ? w * g[k] : w; } };
struct SrcOutCd { const float* W; const float* wp; const float* sc;
    __device__ __forceinline__ float operator()(int k, int n) const {
        if (k >= 512) return W[(size_t)k * 1024 + n];
        const int gi = k >> 7, i = k & 127; const float* wr_ = wp + ((size_t)gi * 128 + i) * 128; const float* s = sc + gi * 128; const float* wc_ = W + (size_t)(gi * 128) * 1024 + n;
        float a = 0.f;
        for (int j = 0; j < 128; ++j) a += wr_[j] * s[j] * wc_[(size_t)j * 1024];
        return a; } };

template <class F>
__device__ void conv_weight(int wv, float* tile, const F& src, bf16_t* dst, int K, int N, int Npad, int& tcount) {
    const int nkt = K / 64, nnt = Npad / 64, tot = nkt * nnt, tid = opaque_tid(wv), nb = gridDim.x, bid = blockIdx.x;
    for (int t = 0; t < tot; ++t) {
        if ((tcount + t) % nb != bid) continue;
        const int k0 = (t % nkt) * 64, n0 = (t / nkt) * 64;
        __syncthreads();
#pragma unroll
        for (int i = 0; i < 8; ++i) { const int e = tid + i * 512, ik = e >> 6, jn = e & 63; tile[ik * 65 + jn] = (n0 + jn < N) ? src(k0 + ik, n0 + jn) : 0.f; }
        __syncthreads();
#pragma unroll
        for (int i = 0; i < 4; ++i) { const int e = tid + i * 512, jn = e >> 5, ik = (e & 31) * 2;
            *(unsigned*)(dst + (size_t)(n0 + jn) * K + k0 + ik) = pk2(tile[ik * 65 + jn], tile[(ik + 1) * 65 + jn]); }
    }
    tcount += tot;
}

__device__ void phase0(int wv, const Params& p, float* smem) {
    bf16_t* WB = (bf16_t*)(p.ws + WS_WB);
    int tc = 0;
    conv_weight(wv, smem, SrcPlain{p.in[I_WINAB], p.in[I_NMIX], 3080}, WB + WO_IN_AB, 1024, 3080, LDZ, tc);
    conv_weight(wv, smem, SrcPlain{p.in[I_WOUTAB], nullptr, 1024}, WB + WO_OUT_AB, 1024, 1024, 1024, tc);
    conv_weight(wv, smem, SrcPlain{p.in[I_WUP], p.in[I_NFFN], 4096}, WB + WO_UP0, 1024, 4096, 4096, tc);
    conv_weight(wv, smem, SrcPlain{p.in[I_WDOWN], nullptr, 1024}, WB + WO_DOWN0, 4096, 1024, 1024, tc);
    conv_weight(wv, smem, SrcPlain{p.in[I_WGATE], p.in[I_NPE], 1024}, WB + WO_GATE0, 1024, 1024, 1024, tc);
    conv_weight(wv, smem, SrcPlain{p.in[I_WPROJ], nullptr, 1024}, WB + WO_PROJ0, 256, 1024, 1024, tc);
    conv_weight(wv, smem, SrcPlain{p.in[I_WINCD], p.in[I_NMIX] + 1024, 1024}, WB + WO_IN_CD, 1024, 1024, 1024, tc);
    conv_weight(wv, smem, SrcPlain{p.in[I_WGLU], nullptr, 512}, WB + WO_GLU, 512, 512, 512, tc);
    conv_weight(wv, smem, SrcOutCd{p.in[I_WOUTCD], p.in[I_WPOOL], p.in[I_PSCALE]}, WB + WO_OUT_CD, 1024, 1024, 1024, tc);
    conv_weight(wv, smem, SrcPlain{p.in[I_WUP] + (size_t)1024 * 4096, p.in[I_NFFN] + 1024, 4096}, WB + WO_UP1, 1024, 4096, 4096, tc);
    conv_weight(wv, smem, SrcPlain{p.in[I_WDOWN] + (size_t)4096 * 1024, nullptr, 1024}, WB + WO_DOWN1, 4096, 1024, 1024, tc);
    conv_weight(wv, smem, SrcPlain{p.in[I_WGATE] + (size_t)1024 * 1024, p.in[I_NPE] + 1024, 1024}, WB + WO_GATE1, 1024, 1024, 1024, tc);
    conv_weight(wv, smem, SrcPlain{p.in[I_WPROJ] + (size_t)256 * 1024, nullptr, 1024}, WB + WO_PROJ1, 256, 1024, 1024, tc);
    const int tid0 = opaque_tid(wv), lane = tid0 & 63, gw = blockIdx.x * 8 + (tid0 >> 6), nw = gridDim.x * 8;
    bf16_t* X = (bf16_t*)(p.ws + WS_X); float* ss = (float*)(p.ws + WS_SS);
    for (int row = gw; row < MROWS; row += nw) {
        const float* xr = row < MP ? p.in[I_XP] + (size_t)row * 1024 : p.in[I_XS] + (size_t)(row - MP) * 1024;
        float s = 0.f;
#pragma unroll
        for (int i = 0; i < 4; ++i) { const f32x4 v = *(const f32x4*)(xr + (i * 64 + lane) * 4); s += (v[0] * v[0] + v[1] * v[1]) + (v[2] * v[2] + v[3] * v[3]);
            u32x2 w; w.x = pk2(v[0], v[1]); w.y = pk2(v[2], v[3]); *(u32x2*)(X + (size_t)row * 1024 + (i * 64 + lane) * 4) = w; }
        s = wave_sum(s);
        if (lane == 0) ss[row] = s;
    }
    for (int i = blockIdx.x * 512 + tid0; i < 6 * MROWS; i += gridDim.x * 512) ss[MROWS + i] = 0.f;
}

template <int NW>
__device__ void delta_item(int wv, const Params& p, float* smem, bool sample, int b, int h, int col0) {
    constexpr int NC = NW * 4, CH = 256 + NC;
    const int tid = opaque_tid(wv), lane = tid & 63, wid = tid >> 6;
    const int T = sample ? 8 : 2048;
    const int row0 = sample ? MP + b * 8 : b * 2048;
    const bf16_t* Z = (const bf16_t*)(p.ws + WS_BIG);
    float* ORAW = (float*)(p.ws + WS_X);
    const float* cw = p.in[I_CONVW]; const float* sconv = p.in[I_SCONV] + (size_t)b * 3 * 1536;
    float* qs = smem; float* ks = qs + 64 * 128; float* vs = ks + 64 * 128; float* os = vs + 64 * 32; float* ab = os + 64 * 32;
    const int part = lane & 15, cl = lane >> 4, col = col0 + wid * 4 + cl;
    float S[8];
    if (wid < NW) {
        if (sample) { const float* sp = p.in[I_SDELTA] + ((size_t)(b * 4 + h) * 128) * 128 + col;
#pragma unroll
            for (int i = 0; i < 8; ++i) { const int d = (i >> 2) * 64 + part * 4 + (i & 3); S[i] = sp[(size_t)d * 128]; } }
        else {
#pragma unroll
            for (int i = 0; i < 8; ++i) S[i] = 0.f; }
    }
    const float aexp = __expf(p.in[I_ALOG][h]), dtb = p.in[I_DTB][h];
    for (int t0 = 0; t0 < T; t0 += 64) {
        const int TC = (T - t0) < 64 ? (T - t0) : 64;
        __syncthreads();
        for (int idx = tid; idx < TC * CH; idx += 512) {
            const int tt = idx / CH, c = idx - tt * CH; int zc; float* dst;
            if (c < 128) { zc = h * 128 + c; dst = qs + tt * 128 + c; }
            else if (c < 256) { zc = 512 + h * 128 + (c - 128); dst = ks + tt * 128 + (c - 128); }
            else { zc = 1024 + h * 128 + col0 + (c - 256); dst = vs + tt * 32 + (c - 256); }
            const int t = t0 + tt; float a = 0.f;
#pragma unroll
            for (int i = 0; i < 4; ++i) { const int tp = t - 3 + i; float zv;
                if (tp >= 0) zv = bf2f(Z[(size_t)(row0 + tp) * LDZ + zc]); else zv = sample ? sconv[(tp + 3) * 1536 + zc] : 0.f;
                a += cw[i * 1536 + zc] * zv; }
            *dst = siluf_(a);
        }
        if (tid < TC) { const size_t r = (size_t)(row0 + t0 + tid) * LDZ; const float zb = bf2f(Z[r + 2048 + h]), za = bf2f(Z[r + 2052 + h]) + dtb;
            const float sp = za > 20.f ? za : log1pf(__expf(za)); ab[tid * 2] = __expf(-aexp * sp); ab[tid * 2 + 1] = sigmoidf_(zb); }
        __syncthreads();
        for (int v = wid; v < 2 * TC; v += 8) { float* arr = (v & 1) ? ks : qs; const int tt = v >> 1; const float x0 = arr[tt * 128 + lane], x1 = arr[tt * 128 + 64 + lane];
            const float s = wave_sum(x0 * x0 + x1 * x1); const float sc = rsqrtf(s + EPSF) * ((v & 1) ? 1.0f : 0.08838834764831845f);
            arr[tt * 128 + lane] = x0 * sc; arr[tt * 128 + 64 + lane] = x1 * sc; }
        __syncthreads();
        if (wid < NW) {
            for (int tt = 0; tt < TC; ++tt) {
                const f32x4 ka = *(const f32x4*)(ks + tt * 128 + part * 4), kb = *(const f32x4*)(ks + tt * 128 + 64 + part * 4);
                const f32x4 qa = *(const f32x4*)(qs + tt * 128 + part * 4), qb = *(const f32x4*)(qs + tt * 128 + 64 + part * 4);
                const float a = ab[tt * 2], beta = ab[tt * 2 + 1], v = vs[tt * 32 + wid * 4 + cl];
                float d = (S[0] * ka[0] + S[1] * ka[1]) + (S[2] * ka[2] + S[3] * ka[3]) + (S[4] * kb[0] + S[5] * kb[1]) + (S[6] * kb[2] + S[7] * kb[3]);
                d = row16_sum(d);
                const float uu = beta * (v - a * d);
#pragma unroll
                for (int i = 0; i < 4; ++i) { S[i] = a * S[i] + ka[i] * uu; S[4 + i] = a * S[4 + i] + kb[i] * uu; }
                float o = (S[0] * qa[0] + S[1] * qa[1]) + (S[2] * qa[2] + S[3] * qa[3]) + (S[4] * qb[0] + S[5] * qb[1]) + (S[6] * qb[2] + S[7] * qb[3]);
                o = row16_sum(o);
                if (part == 0) os[tt * 32 + wid * 4 + cl] = o;
            }
        }
        __syncthreads();
        for (int idx = tid; idx < TC * NC; idx += 512) { const int tt = idx / NC, c = idx - tt * NC; ORAW[(size_t)(row0 + t0 + tt) * 512 + h * 128 + col0 + c] = os[tt * 32 + c]; }
    }
    if (wid < NW) {
        float* op = p.out + (sample ? O_DELTA_S : O_DELTA_P) + ((size_t)(b * 4 + h) * 128) * 128 + col;
#pragma unroll
        for (int i = 0; i < 8; ++i) { const int d = (i >> 2) * 64 + part * 4 + (i & 3); op[(size_t)d * 128] = S[i]; }
    }
}

__device__ void phase2a(int wv, const Params& p, float* smem) {
    const int nb = gridDim.x, bid = blockIdx.x;
    for (int it = bid; it < 256; it += nb) { const int bh = it >> 3, sl = it & 7; delta_item<4>(wv, p, smem, false, bh >> 2, bh & 3, sl * 16); }
    for (int it = bid; it < 2048; it += nb) { const int bh = it >> 2, sl = it & 3; delta_item<8>(wv, p, smem, true, bh >> 2, bh & 3, sl * 32); }
}

__device__ void sgu_prompt_item(int wv, const Params& p, float* smem, int b, int nch, int g) {
    const int tid = opaque_tid(wv), lane = tid & 63, wid = tid >> 6;
    const bf16_t* Z = (const bf16_t*)(p.ws + WS_BIG); bf16_t* Mix = (bf16_t*)(p.ws + WS_Y);
    float* vS = smem; float* wS = smem + 128 * 128; float* st = smem + 2 * 128 * 128;
    const int row0 = b * 2048 + nch * 128;
    __syncthreads();
    for (int t = wid; t < 128; t += 8) {
        const u32x4 raw = *(const u32x4*)(Z + (size_t)(row0 + t) * LDZ + 2568 + lane * 8); float x[8];
#pragma unroll
        for (int i = 0; i < 4; ++i) { x[2 * i] = geluf_(__uint_as_float(raw[i] << 16)); x[2 * i + 1] = geluf_(__uint_as_float(raw[i] & 0xffff0000u)); }
        float s = 0.f;
#pragma unroll
        for (int i = 0; i < 8; ++i) s += x[i];
        const float mean = wave_sum(s) * (1.0f / 512.0f); float q = 0.f;
#pragma unroll
        for (int i = 0; i < 8; ++i) { const float d = x[i] - mean; q += d * d; }
        const float var = wave_sum(q) * (1.0f / 512.0f);
        if (lane == 0) { st[t * 2] = mean; st[t * 2 + 1] = rsqrtf(var + EPSF); }
    }
    {
        const float* wsp = p.in[I_WSP] + (size_t)g * 128 * 128;
        for (int idx = tid; idx < 128 * 128; idx += 512) { const int t = idx >> 7, s = idx & 127; wS[idx] = (s <= t) ? wsp[idx] : 0.f; }
    }
    __syncthreads();
    {
        const float* lg = p.in[I_LNG]; const float* lb = p.in[I_LNB];
        for (int idx = tid; idx < 128 * 128; idx += 512) { const int s = idx >> 7, c = idx & 127, ch = g * 128 + c;
            const float x = geluf_(bf2f(Z[(size_t)(row0 + s) * LDZ + 2568 + ch])); const float v = (x - st[s * 2]) * st[s * 2 + 1] * lg[ch] + lb[ch];
            vS[idx] = v;
            if (nch == 15) p.out[O_SGUV_P + ((size_t)b * 128 + s) * 512 + ch] = v; }
    }
    __syncthreads();
    const int c = tid & 127, tq = tid >> 7; const float* bsp = p.in[I_BSP] + g * 128;
    for (int jj = 0; jj < 8; ++jj) {
        const int tb = tq + 4 * jj; float a0 = 0.f, a1 = 0.f, a2 = 0.f, a3 = 0.f;
        for (int s4 = 0; s4 <= 4 * tb; s4 += 4) {
            const float v0 = vS[(s4 + 0) * 128 + c], v1 = vS[(s4 + 1) * 128 + c], v2 = vS[(s4 + 2) * 128 + c], v3 = vS[(s4 + 3) * 128 + c];
            const f32x4 w0 = *(const f32x4*)(wS + (4 * tb + 0) * 128 + s4), w1 = *(const f32x4*)(wS + (4 * tb + 1) * 128 + s4), w2 = *(const f32x4*)(wS + (4 * tb + 2) * 128 + s4), w3 = *(const f32x4*)(wS + (4 * tb + 3) * 128 + s4);
            a0 += w0[0] * v0 + w0[1] * v1 + w0[2] * v2 + w0[3] * v3; a1 += w1[0] * v0 + w1[1] * v1 + w1[2] * v2 + w1[3] * v3;
            a2 += w2[0] * v0 + w2[1] * v1 + w2[2] * v2 + w2[3] * v3; a3 += w3[0] * v0 + w3[1] * v1 + w3[2] * v2 + w3[3] * v3;
        }
        const float accs[4] = {a0, a1, a2, a3};
#pragma unroll
        for (int e = 0; e < 4; ++e) { const int t = 4 * tb + e; const float u = geluf_(bf2f(Z[(size_t)(row0 + t) * LDZ + 2056 + g * 128 + c]));
            Mix[(size_t)(row0 + t) * 1024 + 512 + g * 128 + c] = f2bf(u * (accs[e] + bsp[t])); }
    }
}

__device__ void sgu_sample_item(int wv, const Params& p, float* smem, int b) {
    const int tid = opaque_tid(wv), lane = tid & 63, wid = tid >> 6;
    const bf16_t* Z = (const bf16_t*)(p.ws + WS_BIG); bf16_t* Mix = (bf16_t*)(p.ws + WS_Y);
    float* vS = smem;
    const int row0 = MP + b * 8;
    __syncthreads();
    {   const int t = wid; const u32x4 raw = *(const u32x4*)(Z + (size_t)(row0 + t) * LDZ + 2568 + lane * 8); float x[8];
#pragma unroll
        for (int i = 0; i < 4; ++i) { x[2 * i] = geluf_(__uint_as_float(raw[i] << 16)); x[2 * i + 1] = geluf_(__uint_as_float(raw[i] & 0xffff0000u)); }
        float s = 0.f;
#pragma unroll
        for (int i = 0; i < 8; ++i) s += x[i];
        const float mean = wave_sum(s) * (1.0f / 512.0f); float q = 0.f;
#pragma unroll
        for (int i = 0; i < 8; ++i) { const float d = x[i] - mean; q += d * d; }
        const float rs = rsqrtf(wave_sum(q) * (1.0f / 512.0f) + EPSF);
#pragma unroll
        for (int i = 0; i < 8; ++i) { const int ch = lane * 8 + i; const float v = (x[i] - mean) * rs * p.in[I_LNG][ch] + p.in[I_LNB][ch]; vS[t * 512 + ch] = v; p.out[O_SGUV_S + ((size_t)b * 8 + t) * 512 + ch] = v; }
    }
    __syncthreads();
    const int ch = tid, g = ch >> 7; const float* wsp = p.in[I_WSP] + (size_t)g * 128 * 128; const float* bsp = p.in[I_BSP] + g * 128;
    for (int t = 0; t < 8; ++t) { float a = bsp[t];
        for (int s = 0; s <= t; ++s) a += wsp[t * 128 + s] * vS[s * 512 + ch];
        const float u = geluf_(bf2f(Z[(size_t)(row0 + t) * LDZ + 2056 + ch]));
        Mix[(size_t)(row0 + t) * 1024 + 512 + ch] = f2bf(u * a); }
}

__device__ void phase2b(int wv, const Params& p, float* smem) {
    const int tid = opaque_tid(wv), lane = tid & 63, nb = gridDim.x, bid = blockIdx.x, gw = bid * 8 + (tid >> 6), nw = nb * 8;
    const bf16_t* Z = (const bf16_t*)(p.ws + WS_BIG); bf16_t* Mix = (bf16_t*)(p.ws + WS_Y); const float* ORAW = (const float*)(p.ws + WS_X);
    for (int it = gw; it < MROWS * 4; it += nw) { const int row = it >> 2, h = it & 3, c = h * 128 + lane * 2;
        const float o0 = ORAW[(size_t)row * 512 + c], o1 = ORAW[(size_t)row * 512 + c + 1];
        const float rs = rsqrtf(wave_sum(o0 * o0 + o1 * o1) * (1.0f / 128.0f) + EPSF);
        const unsigned zg = *(const unsigned*)(Z + (size_t)row * LDZ + 1536 + c);
        const float g0 = siluf_(__uint_as_float(zg << 16)), g1 = siluf_(__uint_as_float(zg & 0xffff0000u));
        *(unsigned*)(Mix + (size_t)row * 1024 + c) = pk2(o0 * rs * p.in[I_NORMO][lane * 2] * g0, o1 * rs * p.in[I_NORMO][lane * 2 + 1] * g1); }
    for (int i = bid * 512 + tid; i < 8 * 3 * 1536; i += nb * 512) { const int c = i % 1536, r = (i / 1536) % 3, b = i / (3 * 1536); p.out[O_CONV_P + i] = bf2f(Z[(size_t)(b * 2048 + 2045 + r) * LDZ + c]); }
    for (int i = bid * 512 + tid; i < 128 * 3 * 1536; i += nb * 512) { const int c = i % 1536, r = (i / 1536) % 3, b = i / (3 * 1536); p.out[O_CONV_S + i] = bf2f(Z[(size_t)(MP + b * 8 + 5 + r) * LDZ + c]); }
    for (int it = bid; it < 512; it += nb) sgu_prompt_item(wv, p, smem, it >> 6, (it >> 2) & 15, it & 3);
    for (int it = bid; it < 128; it += nb) sgu_sample_item(wv, p, smem, it);
}

__device__ void s5_item(const Params& p, float* wl  , bool sample, int b, int g) {
    const int lane = lane_id_(), lr16 = lane & 15, lq = lane >> 4;
    const float* Z1 = (const float*)(p.ws + WS_BIG + BIG_Z1); bf16_t* YG = (bf16_t*)(p.ws + WS_BIG + BIG_YG);
    float* buL = wl; float* sL = wl + 16 * 132;
    const int T = sample ? 8 : 2048, row0 = sample ? MP + b * 8 : b * 2048;
    const float dt = __expf(p.in[I_LOGDT][g]);
    const float* lamre = p.in[I_LAMRE] + g * 64; const float* lamim = p.in[I_LAMIM] + g * 64;
    float lbr, lbi;
    { const float x = lamre[lane] * dt, y = lamim[lane] * dt, ex = __expf(x); float sn, cs; sincosf(y, &sn, &cs); lbr = ex * cs; lbi = ex * sn; }
    float sr = 0.f, si = 0.f;
    if (sample) { sr = p.in[I_S5RE][((size_t)b * 32 + g) * 64 + lane]; si = p.in[I_S5IM][((size_t)b * 32 + g) * 64 + lane]; }
    bf16x8 bfr[8];
    {
        float fre[4], fim[4];
#pragma unroll
        for (int j = 0; j < 4; ++j) { const int nn = j * 16 + lr16; const float lr = lamre[nn], li = lamim[nn], x = lr * dt, y = li * dt; float sn, cs; sincosf(y, &sn, &cs);
            const float ex = __expf(x), em = expm1f(x), sh = sinf(0.5f * y); const float re1 = em * cs - 2.f * sh * sh, im1 = ex * sn, den = 1.0f / (lr * lr + li * li);
            fre[j] = (re1 * lr + im1 * li) * den; fim[j] = (im1 * lr - re1 * li) * den; }
#pragma unroll
        for (int j = 0; j < 8; ++j) { const int nn = (j & 3) * 16 + lr16; const bool im = j >= 4; unsigned w[4] = {0u, 0u, 0u, 0u};
            if (lq < 2) { const float* br = p.in[I_BRE] + ((size_t)g * 64 + nn) * 16 + lq * 8; const float* bi = p.in[I_BIM] + ((size_t)g * 64 + nn) * 16 + lq * 8; float v[8];
#pragma unroll
                for (int i = 0; i < 8; ++i) v[i] = im ? (fre[j & 3] * bi[i] + fim[j & 3] * br[i]) : (fre[j & 3] * br[i] - fim[j & 3] * bi[i]);
#pragma unroll
                for (int i = 0; i < 4; ++i) w[i] = pk2(v[2 * i], v[2 * i + 1]); }
            bfr[j] = __builtin_bit_cast(bf16x8, (u32x4){w[0], w[1], w[2], w[3]}); }
    }
    bf16x8 cfr[4];
#pragma unroll
    for (int kk = 0; kk < 4; ++kk) { const int n0 = kk * 32 + lq * 8; const float* src = (n0 < 64 ? p.in[I_CRE] : p.in[I_CIM]) + ((size_t)g * 16 + lr16) * 64 + (n0 & 63); const float sg = n0 < 64 ? 1.f : -1.f; unsigned w[4];
#pragma unroll
        for (int i = 0; i < 4; ++i) w[i] = pk2(sg * src[2 * i], sg * src[2 * i + 1]);
        cfr[kk] = __builtin_bit_cast(bf16x8, (u32x4){w[0], w[1], w[2], w[3]}); }
    const float dsk = p.in[I_DSKIP][g * 16 + lr16];
    for (int t0 = 0; t0 < T; t0 += 16) {
        const int nv = (T - t0) < 16 ? (T - t0) : 16;
        bf16x8 afr; { unsigned w[4] = {0u, 0u, 0u, 0u};
            if (lq < 2 && lr16 < nv) { const float* up = Z1 + (size_t)(row0 + t0 + lr16) * 1024 + 512 + g * 16 + lq * 8; const f32x4 a = *(const f32x4*)up, c4 = *(const f32x4*)(up + 4);
                w[0] = pk2(a[0], a[1]); w[1] = pk2(a[2], a[3]); w[2] = pk2(c4[0], c4[1]); w[3] = pk2(c4[2], c4[3]); }
            afr = __builtin_bit_cast(bf16x8, (u32x4){w[0], w[1], w[2], w[3]}); }
#pragma unroll
        for (int j = 0; j < 8; ++j) { f32x4 acc = {0.f, 0.f, 0.f, 0.f}; acc = __builtin_amdgcn_mfma_f32_16x16x32_bf16(afr, bfr[j], acc, 0, 0, 0);
#pragma unroll
            for (int jj = 0; jj < 4; ++jj) buL[(lq * 4 + jj) * 132 + j * 16 + lr16] = acc[jj]; }
        asm volatile("s_waitcnt lgkmcnt(0)" ::: "memory");
        for (int tt = 0; tt < nv; ++tt) { const float bur = buL[tt * 132 + lane], bui = buL[tt * 132 + 64 + lane];
            const float nr = lbr * sr - lbi * si + bur, ni = lbr * si + lbi * sr + bui; sr = nr; si = ni;
            sL[tt * 132 + lane] = nr; sL[tt * 132 + 64 + lane] = ni; }
        asm volatile("s_waitcnt lgkmcnt(0)" ::: "memory");
        f32x4 yacc = {0.f, 0.f, 0.f, 0.f};
#pragma unroll
        for (int kk = 0; kk < 4; ++kk) { const float* sp = sL + lr16 * 132 + kk * 32 + lq * 8; const f32x4 a = *(const f32x4*)sp, c4 = *(const f32x4*)(sp + 4);
            const bf16x8 sfr = __builtin_bit_cast(bf16x8, (u32x4){pk2(a[0], a[1]), pk2(a[2], a[3]), pk2(c4[0], c4[1]), pk2(c4[2], c4[3])});
            yacc = __builtin_amdgcn_mfma_f32_16x16x32_bf16(sfr, cfr[kk], yacc, 0, 0, 0); }
#pragma unroll
        for (int jj = 0; jj < 4; ++jj) { const int tok = lq * 4 + jj;
            if (tok < nv) { const size_t r = (size_t)(row0 + t0 + tok); const float u = Z1[r * 1024 + 512 + g * 16 + lr16];
                YG[r * 512 + g * 16 + lr16] = f2bf(geluf_(yacc[jj] + dsk * u)); } }
        asm volatile("s_waitcnt lgkmcnt(0)" ::: "memory");
    }
    float* ore = p.out + (sample ? O_S5RE_S : O_S5RE_P) + ((size_t)b * 32 + g) * 64; float* oim = p.out + (sample ? O_S5IM_S : O_S5IM_P) + ((size_t)b * 32 + g) * 64;
    ore[lane] = sr; oim[lane] = si;
}

__device__ void phase8a(int wv, const Params& p, float* smem) {
    const int tid = opaque_tid(wv), lane = tid & 63, wid = __builtin_amdgcn_readfirstlane(tid >> 6), nb = gridDim.x, bid = blockIdx.x;
    float* wl = smem + wid * (2 * 16 * 132);
    const float* Z1 = (const float*)(p.ws + WS_BIG + BIG_Z1); bf16_t* Mix = (bf16_t*)(p.ws + WS_Y);
    if (wid == 0) { for (int it = bid; it < 256; it += nb) s5_item(p, wl, false, it >> 5, it & 31); return; }
    const int hw = bid * 7 + (wid - 1), nh = nb * 7;
    for (int it = hw; it < 4096; it += nh) s5_item(p, wl, true, it >> 5, it & 31);
    for (int it = hw; it < MROWS * 8; it += nh) { const int row = it >> 3, ck = it & 7, c = ck * 64 + lane, gi = ck >> 1, win = 2 << gi;
        const bool smp = row >= MP; const int b = smp ? (row - MP) >> 3 : row >> 11, t = smp ? (row - MP) & 7 : row & 2047, rbase = row - t;
        float s = 0.f;
        for (int i = 0; i < win; ++i) { const int tp = t - i; float x;
            if (tp >= 0) x = Z1[(size_t)(rbase + tp) * 1024 + c]; else x = smp ? p.in[I_SPOOL][((size_t)b * 15 + 15 + tp) * 512 + c] : 0.f;
            s += x; }
        const float cnt = smp ? (float)win : (float)((t + 1) < win ? (t + 1) : win);
        Mix[(size_t)row * 1024 + c] = f2bf(s / cnt - Z1[(size_t)row * 1024 + c]); }
    for (int i = hw * 64 + lane; i < 8 * 15 * 512; i += nh * 64) { const int c = i & 511, r = (i >> 9) % 15, b = i / (15 * 512); p.out[O_POOL_P + i] = Z1[(size_t)(b * 2048 + 2033 + r) * 1024 + c]; }
    for (int i = hw * 64 + lane; i < 128 * 15 * 512; i += nh * 64) { const int c = i & 511, r = (i >> 9) % 15, b = i / (15 * 512);
        p.out[O_POOL_S + i] = r < 7 ? p.in[I_SPOOL][((size_t)b * 15 + r + 8) * 512 + c] : Z1[(size_t)(MP + b * 8 + r - 7) * 1024 + c]; }
}

__device__ void convert_p(int wv, const Params& p, int layer, bf16_t* dst) {
    const float* pp = p.in[I_PP] + (size_t)layer * MP * 256; const float* ps = p.in[I_PS] + (size_t)layer * 1024 * 256;
    for (size_t i = (size_t)blockIdx.x * 512 + opaque_tid(wv); i < (size_t)MROWS * 64; i += (size_t)gridDim.x * 512) {
        const size_t e = i * 4; const f32x4 v = e < (size_t)MP * 256 ? *(const f32x4*)(pp + e) : *(const f32x4*)(ps + (e - (size_t)MP * 256));
        u32x2 w; w.x = pk2(v[0], v[1]); w.y = pk2(v[2], v[3]); *(u32x2*)(dst + e) = w; }
}

__global__ void __launch_bounds__(512) fwd_megakernel(Params p) {
    extern __shared__ __attribute__((aligned(16))) unsigned char dynlds[];
    cg::grid_group grid = cg::this_grid();
    PG8_LAS unsigned char* lds = (PG8_LAS unsigned char*)dynlds;
    float* smem = (float*)dynlds;
    unsigned char* ws = p.ws;
    bf16_t* WB = (bf16_t*)(ws + WS_WB); bf16_t* X = (bf16_t*)(ws + WS_X); bf16_t* Y = (bf16_t*)(ws + WS_Y); float* ss = (float*)(ws + WS_SS);
    bf16_t* BIGb = (bf16_t*)(ws + WS_BIG);
    float* H = p.out + O_Y;

    const int wv = __builtin_amdgcn_readfirstlane((int)threadIdx.x >> 6);
    phase0(wv, p, smem);
    grid.sync();
    run_gemm(wv, lds, X, WB + WO_IN_AB, MROWS, LDZ, 1024, EpiZ{BIGb, LDZ, ss});
    grid.sync();
    phase2a(wv, p, smem);
    grid.sync();
    phase2b(wv, p, smem);
    grid.sync();
    run_gemm(wv, lds, Y, WB + WO_OUT_AB, MROWS, 1024, 1024, EpiRes{p.in[I_XP], p.in[I_XS], H, X, ss + 1 * MROWS});
    grid.sync();
    run_gemm(wv, lds, X, WB + WO_UP0, MROWS, DFF, 1024, EpiUp{BIGb, ss + 1 * MROWS});
    grid.sync();
    run_gemm(wv, lds, BIGb, WB + WO_DOWN0, MROWS, 1024, DFF, EpiRes{H, H + (size_t)MP * 1024, H, Y, ss + 2 * MROWS});
    convert_p(wv, p, 0, WB + WO_IN_AB);
    grid.sync();
    run_gemm(wv, lds, Y, WB + WO_GATE0, MROWS, 1024, 1024, EpiGate{(f32x4*)(ws + WS_BIG), ss + 2 * MROWS});
    run_gemm(wv, lds, WB + WO_IN_AB, WB + WO_PROJ0, MROWS, 1024, 256, EpiProj{(const f32x4*)(ws + WS_BIG), H, X, ss + 3 * MROWS});
    grid.sync();
    run_gemm(wv, lds, X, WB + WO_IN_CD, MROWS, 1024, 1024, EpiZ1{(float*)(ws + WS_BIG + BIG_Z1), ss + 3 * MROWS});
    grid.sync();
    phase8a(wv, p, smem);
    grid.sync();
    run_gemm(wv, lds, (const bf16_t*)(ws + WS_BIG + BIG_YG), WB + WO_GLU, MROWS, 512, 512, EpiGlu{(const bf16_t*)(ws + WS_BIG + BIG_YG), p.in[I_BGLU], Y});
    grid.sync();
    run_gemm(wv, lds, Y, WB + WO_OUT_CD, MROWS, 1024, 1024, EpiRes{H, H + (size_t)MP * 1024, H, X, ss + 4 * MROWS});
    grid.sync();
    run_gemm(wv, lds, X, WB + WO_UP1, MROWS, DFF, 1024, EpiUp{BIGb, ss + 4 * MROWS});
    grid.sync();
    run_gemm(wv, lds, BIGb, WB + WO_DOWN1, MROWS, 1024, DFF, EpiRes{H, H + (size_t)MP * 1024, H, Y, ss + 5 * MROWS});
    convert_p(wv, p, 1, WB + WO_UP0);
    grid.sync();
    run_gemm(wv, lds, Y, WB + WO_GATE1, MROWS, 1024, 1024, EpiGate{(f32x4*)(ws + WS_BIG), ss + 5 * MROWS});
    run_gemm(wv, lds, WB + WO_UP0, WB + WO_PROJ1, MROWS, 1024, 256, EpiProj{(const f32x4*)(ws + WS_BIG), H, X, ss + 6 * MROWS});
    grid.sync();
    {
        const int tidf = opaque_tid(wv), lane = tidf & 63, gw = blockIdx.x * 8 + (tidf >> 6), nw = gridDim.x * 8; const float* gf = p.in[I_NFINAL]; const float* s6 = ss + 6 * MROWS;
        for (int row = gw; row < MROWS; row += nw) { const float rs = rstd_of(s6, row); float* hr = H + (size_t)row * 1024;
#pragma unroll
            for (int i = 0; i < 4; ++i) { const int c = (i * 64 + lane) * 4; *(f32x4*)(hr + c) = *(const f32x4*)(hr + c) * rs * *(const f32x4*)(gf + c); } }
    }
}

extern "C" void kernel_launch(void* const* d_in, const int* in_sizes, int n_in, void* d_out, int out_size, void* d_ws, size_t ws_size, hipStream_t stream) {
    static int grid_blocks = 0;
    if (grid_blocks == 0) {
        if (n_in != NIN || (size_t)out_size != O_END || ws_size < WS_END) { fprintf(stderr, "kernel_launch: unexpected shapes n_in %d out %d ws %zu\n", n_in, out_size, ws_size); grid_blocks = -1; return; }
        int dev = 0, cus = 0, per_cu = 0;
        hipGetDevice(&dev);
        hipDeviceGetAttribute(&cus, hipDeviceAttributeMultiprocessorCount, dev);
        if (hipFuncSetAttribute((const void*)fwd_megakernel, hipFuncAttributeMaxDynamicSharedMemorySize, LDS_BYTES) != hipSuccess) { fprintf(stderr, "kernel_launch: hipFuncSetAttribute failed\n"); grid_blocks = -1; return; }
        if (hipOccupancyMaxActiveBlocksPerMultiprocessor(&per_cu, (const void*)fwd_megakernel, 512, LDS_BYTES) != hipSuccess || per_cu < 1) { fprintf(stderr, "kernel_launch: occupancy query failed (%d)\n", per_cu); per_cu = 1; (void)hipGetLastError(); }
        grid_blocks = cus * per_cu;
    }
    if (grid_blocks < 0) return;
    Params p{};
    for (int i = 0; i < NIN; ++i) p.in[i] = (const float*)d_in[i];
    p.out = (float*)d_out; p.ws = (unsigned char*)d_ws;
    void* args[] = {&p};
    hipError_t e = hipLaunchCooperativeKernel((const void*)fwd_megakernel, dim3(grid_blocks), dim3(512), args, LDS_BYTES, stream);
    if (e != hipSuccess) fprintf(stderr, "cooperative launch failed: %s (grid %d)\n", hipGetErrorString(e), grid_blocks);
}
```

```cpp
#include <hip/hip_runtime.h>
#include <hip/hip_cooperative_groups.h>
#include <cstdio>
namespace cg = cooperative_groups;

__device__ __forceinline__ int lane_id_() { return (int)__builtin_amdgcn_mbcnt_hi(~0u, __builtin_amdgcn_mbcnt_lo(~0u, 0u)); }
__device__ __forceinline__ int opaque_tid(int wv) { int t; asm volatile("v_mbcnt_lo_u32_b32 %0, -1, 0\n\tv_mbcnt_hi_u32_b32 %0, -1, %0\n\tv_lshl_add_u32 %0, %1, 6, %0" : "=&v"(t) : "s"(wv)); return t; }
namespace pg8 {
#define PG8_LAS __attribute__((address_space(3)))
typedef unsigned short bf16_t;
typedef short bf16x8 __attribute__((ext_vector_type(8)));
typedef float f32x4 __attribute__((ext_vector_type(4)));
typedef unsigned u32x4 __attribute__((ext_vector_type(4)));
typedef unsigned u32x2 __attribute__((ext_vector_type(2)));
constexpr int BM = 256, BK = 64, HALF = 128, HTB = HALF * BK * 2, STAGE_BYTES = 8 * HTB, NXCD = 8, WGM = 8;

__host__ __device__ __forceinline__ int lds_byte(int r, int c) { const int st = (r >> 4) * 2 + (c >> 5), rr = r & 15, cc = c & 31, ob = rr * 64 + cc * 2; return st * 1024 + (ob ^ (((ob >> 9) & 1) << 5)); }
__host__ __device__ __forceinline__ void stage_rc(int b, int& R, int& C) { const int st = b / 1024, sb = b % 1024, swz = sb ^ (((sb >> 9) & 1) << 5); R = (st >> 1) * 16 + swz / 64; C = (st & 1) * 32 + (swz % 64) / 2; }

struct Unit { int pm, pn; };
struct Gemm { const bf16_t* A; const bf16_t* Bt; int M, N, K; };

struct StaticOrder {
    int nM, nN, nwg, G, c;
    __host__ __device__ void init(int M, int N, int G_, int c_) { nM = M / BM; nN = N / BM; nwg = nM * nN; G = G_; c = c_; }
    __host__ __device__ bool next(int i, Unit& u) const {
        const long L = (long)i * G + c; if (L >= nwg) return false;
        int wgid = (int)L; { const int q = nwg / NXCD, r = nwg % NXCD, xcd = wgid % NXCD, off = wgid / NXCD; wgid = (xcd < r ? xcd * (q + 1) : r * (q + 1) + (xcd - r) * q) + off; }
        const int nig = WGM * nN, gid = wgid / nig, fm = gid * WGM, gsz = (nM - fm) < WGM ? (nM - fm) : WGM;
        u.pm = fm + ((wgid % nig) % gsz); u.pn = (wgid % nig) / gsz; return true;
    }
};

template <class Epi, class Sched>
__device__ __forceinline__ void gemm_phase(int wv, PG8_LAS unsigned char* lds, const Gemm g, const Sched& S, const Epi& E) {
    const int tid = opaque_tid(wv), wid = __builtin_amdgcn_readfirstlane(tid >> 6), lane = tid & 63, wr = wid >> 2, wc = wid & 3, fr = lane & 15, fq = lane >> 4;
    const int K = g.K, nt = K / BK;
    unsigned voffA[2], voffB[2];
#pragma unroll
    for (int i = 0; i < 2; ++i) { int R, C; stage_rc(tid * 16 + i * 8192, R, C); voffA[i] = (unsigned)(R * K + C) * 2u; voffB[i] = (unsigned)(R * K + C) * 2u; }
    const size_t kstep = (size_t)(BK * 2);
    const size_t hstep = (size_t)HALF * K * 2;
    const size_t tstep = 2 * hstep;
    const unsigned ldsw = (unsigned)wid * 1024u;
    const int aoff = lds_byte(wr * 64 + fr, fq * 8), boff = lds_byte(wc * 32 + fr, fq * 8);
#define PG8_SA(b, h) (((b) * 2 + (h)) * HTB)
#define PG8_SB(b, h) ((4 + (b) * 2 + (h)) * HTB)
#define PG8_STAGE(bufoff, gbase, voff) do { _Pragma("unroll") for (int _i = 0; _i < 2; ++_i) \
        __builtin_amdgcn_global_load_lds((const unsigned*)((const char*)(gbase) + (voff)[_i]), (PG8_LAS unsigned*)(lds + (bufoff) + ldsw + _i * 8192), 16, 0, 0); } while (0)
#define PG8_LDA(dst, b, h) do { _Pragma("unroll") for (int m = 0; m < 4; ++m) _Pragma("unroll") for (int k = 0; k < 2; ++k) dst[m][k] = *(const PG8_LAS bf16x8*)(lds + PG8_SA(b, h) + aoff + m * 2048 + k * 1024); } while (0)
#define PG8_LDB(dst, b, h) do { _Pragma("unroll") for (int n = 0; n < 2; ++n) _Pragma("unroll") for (int k = 0; k < 2; ++k) dst[n][k] = *(const PG8_LAS bf16x8*)(lds + PG8_SB(b, h) + boff + n * 2048 + k * 1024); } while (0)
#define PG8_MMA(ai, bj, At, Bt) do { __builtin_amdgcn_s_setprio(1); _Pragma("unroll") for (int m = 0; m < 4; ++m) _Pragma("unroll") for (int n = 0; n < 2; ++n) _Pragma("unroll") for (int k = 0; k < 2; ++k) \
        acc[ai][bj][m][n] = __builtin_amdgcn_mfma_f32_16x16x32_bf16(Bt[n][k], At[m][k], acc[ai][bj][m][n], 0, 0, 0); __builtin_amdgcn_s_setprio(0); } while (0)
#define PG8_WAIT_V(n) asm volatile("s_waitcnt vmcnt(" #n ")" ::: "memory")
#define PG8_WAIT_L(n) asm volatile("s_waitcnt lgkmcnt(" #n ")" ::: "memory")
#define PG8_BAR __builtin_amdgcn_s_barrier()
#define PG8_SCHED __builtin_amdgcn_sched_barrier(0)
    Unit cur, nxt; int ui = 0;
    if (!S.next(0, cur)) return;
    f32x4 acc[2][2][4][2];
#pragma unroll
    for (int a = 0; a < 2; ++a)
#pragma unroll
        for (int b = 0; b < 2; ++b)
#pragma unroll
            for (int m = 0; m < 4; ++m)
#pragma unroll
                for (int n = 0; n < 2; ++n) acc[a][b][m][n] = (f32x4){0.f, 0.f, 0.f, 0.f};
    bf16x8 At[4][2], B0[2][2], B1[2][2];
    const char* cA = (const char*)g.A + (size_t)cur.pm * tstep; const char* cB = (const char*)g.Bt + (size_t)cur.pn * tstep;
    PG8_STAGE(PG8_SB(0, 0), cB, voffB); PG8_STAGE(PG8_SA(0, 0), cA, voffA); PG8_STAGE(PG8_SB(0, 1), cB + hstep, voffB); PG8_STAGE(PG8_SA(0, 1), cA + hstep, voffA);
    if (wr == 1) PG8_BAR;
    PG8_WAIT_V(4); PG8_BAR;
    PG8_STAGE(PG8_SB(1, 0), cB + kstep, voffB); PG8_STAGE(PG8_SA(1, 0), cA + kstep, voffA); PG8_STAGE(PG8_SB(1, 1), cB + hstep + kstep, voffB);
    PG8_WAIT_V(6); PG8_BAR;
    for (;;) {
        const bool has_next = S.next(ui + 1, nxt);
        const char* nA = has_next ? (const char*)g.A + (size_t)nxt.pm * tstep : cA; const char* nB = has_next ? (const char*)g.Bt + (size_t)nxt.pn * tstep : cB;
        for (int t = 0; t < nt; t += 2) {
            const bool last = (t == nt - 2);
            const char* a1 = cA + (size_t)(t + 1) * kstep;
            const char* a2 = last ? nA : cA + (size_t)(t + 2) * kstep; const char* b2 = last ? nB : cB + (size_t)(t + 2) * kstep;
            const char* a3 = a2 + kstep; const char* b3 = b2 + kstep;
            PG8_LDB(B0, 0, 0); PG8_SCHED; PG8_LDA(At, 0, 0); PG8_STAGE(PG8_SA(1, 1), a1 + hstep, voffA);
            PG8_WAIT_L(8); PG8_BAR; PG8_WAIT_L(0); PG8_MMA(0, 0, At, B0); PG8_BAR; PG8_SCHED;
            PG8_LDB(B1, 0, 1); PG8_STAGE(PG8_SB(0, 0), b2, voffB);
            PG8_BAR; PG8_WAIT_L(0); PG8_MMA(0, 1, At, B1); PG8_BAR;
            PG8_LDA(At, 0, 1); PG8_STAGE(PG8_SA(0, 0), a2, voffA);
            PG8_BAR; PG8_WAIT_L(0); PG8_MMA(1, 0, At, B0); PG8_BAR; PG8_SCHED;
            PG8_STAGE(PG8_SB(0, 1), b2 + hstep, voffB);
            PG8_WAIT_V(6); PG8_BAR; PG8_MMA(1, 1, At, B1); PG8_BAR;
            PG8_LDB(B0, 1, 0); PG8_SCHED; PG8_LDA(At, 1, 0); PG8_STAGE(PG8_SA(0, 1), a2 + hstep, voffA);
            PG8_WAIT_L(8); PG8_BAR; PG8_WAIT_L(0); PG8_MMA(0, 0, At, B0); PG8_BAR; PG8_SCHED;
            PG8_LDB(B1, 1, 1); PG8_STAGE(PG8_SB(1, 0), b3, voffB);
            PG8_BAR; PG8_WAIT_L(0); PG8_MMA(0, 1, At, B1); PG8_BAR;
            PG8_LDA(At, 1, 1); PG8_STAGE(PG8_SA(1, 0), a3, voffA);
            PG8_BAR; PG8_WAIT_L(0); PG8_MMA(1, 0, At, B0); PG8_BAR; PG8_SCHED;
            PG8_STAGE(PG8_SB(1, 1), b3 + hstep, voffB);
            PG8_WAIT_V(6); PG8_BAR; PG8_MMA(1, 1, At, B1); PG8_BAR;
        }
        E(acc, cur, wr, wc, fr, fq);
        if (!has_next) break;
#pragma unroll
        for (int a = 0; a < 2; ++a)
#pragma unroll
            for (int b = 0; b < 2; ++b)
#pragma unroll
                for (int m = 0; m < 4; ++m)
#pragma unroll
                    for (int n = 0; n < 2; ++n) acc[a][b][m][n] = (f32x4){0.f, 0.f, 0.f, 0.f};
        cur = nxt; cA = nA; cB = nB; ++ui;
    }
    PG8_WAIT_V(0);
    if (wr == 0) PG8_BAR;
    PG8_BAR;
#undef PG8_SA
#undef PG8_SB
#undef PG8_STAGE
#undef PG8_LDA
#undef PG8_LDB
#undef PG8_MMA
#undef PG8_WAIT_V
#undef PG8_WAIT_L
#undef PG8_BAR
#undef PG8_SCHED
}
}

using pg8::bf16_t; using pg8::bf16x8; using pg8::f32x4; using pg8::u32x2; using pg8::u32x4; using pg8::Unit;

constexpr int MROWS = 17408, MP = 16384, DM = 1024, LDZ = 3328, DFF = 4096, NIN = 41;
constexpr float EPSF = 1e-6f;
constexpr int LDS_BYTES = 135168;

constexpr size_t WS_BIG = 0;
constexpr size_t BIG_BYTES = (size_t)MROWS * DFF * 2;
constexpr size_t WS_WB = WS_BIG + BIG_BYTES;
constexpr size_t WO_IN_AB = 0;
constexpr size_t WO_OUT_AB = WO_IN_AB + (size_t)LDZ * 1024;
constexpr size_t WO_UP0 = WO_OUT_AB + (size_t)1024 * 1024;
constexpr size_t WO_DOWN0 = WO_UP0 + (size_t)4096 * 1024;
constexpr size_t WO_GATE0 = WO_DOWN0 + (size_t)4096 * 1024;
constexpr size_t WO_PROJ0 = WO_GATE0 + (size_t)1024 * 1024;
constexpr size_t WO_IN_CD = WO_PROJ0 + (size_t)1024 * 256;
constexpr size_t WO_GLU = WO_IN_CD + (size_t)1024 * 1024;
constexpr size_t WO_OUT_CD = WO_GLU + (size_t)512 * 512;
constexpr size_t WO_UP1 = WO_OUT_CD + (size_t)1024 * 1024;
constexpr size_t WO_DOWN1 = WO_UP1 + (size_t)4096 * 1024;
constexpr size_t WO_GATE1 = WO_DOWN1 + (size_t)4096 * 1024;
constexpr size_t WO_PROJ1 = WO_GATE1 + (size_t)1024 * 1024;
constexpr size_t WB_ELEMS = WO_PROJ1 + (size_t)1024 * 256;
constexpr size_t WS_X = WS_WB + WB_ELEMS * 2;
constexpr size_t ABUF_BYTES = (size_t)MROWS * DM * 2;
constexpr size_t WS_Y = WS_X + ABUF_BYTES;
constexpr size_t WS_SS = WS_Y + ABUF_BYTES;
constexpr size_t WS_END = WS_SS + (size_t)7 * MROWS * 4;
static_assert(WS_END <= (size_t)268435456, "workspace over 256 MiB");
constexpr size_t BIG_Z1 = 0;
constexpr size_t BIG_YG = (size_t)MROWS * DM * 4;

constexpr size_t O_Y = 0;
constexpr size_t O_CONV_P = (size_t)MROWS * DM;
constexpr size_t O_DELTA_P = O_CONV_P + 8 * 3 * 1536;
constexpr size_t O_SGUV_P = O_DELTA_P + (size_t)8 * 4 * 128 * 128;
constexpr size_t O_POOL_P = O_SGUV_P + (size_t)8 * 128 * 512;
constexpr size_t O_S5RE_P = O_POOL_P + (size_t)8 * 15 * 512;
constexpr size_t O_S5IM_P = O_S5RE_P + (size_t)8 * 32 * 64;
constexpr size_t O_CONV_S = O_S5IM_P + (size_t)8 * 32 * 64;
constexpr size_t O_DELTA_S = O_CONV_S + (size_t)128 * 3 * 1536;
constexpr size_t O_SGUV_S = O_DELTA_S + (size_t)128 * 4 * 128 * 128;
constexpr size_t O_POOL_S = O_SGUV_S + (size_t)128 * 8 * 512;
constexpr size_t O_S5RE_S = O_POOL_S + (size_t)128 * 15 * 512;
constexpr size_t O_S5IM_S = O_S5RE_S + (size_t)128 * 32 * 64;
constexpr size_t O_END = O_S5IM_S + (size_t)128 * 32 * 64;

enum { I_XP = 0, I_XS, I_SCONV, I_SDELTA, I_SPOOL, I_S5RE, I_S5IM, I_PP, I_PS, I_NMIX, I_NFFN, I_NPE, I_NFINAL, I_WINAB, I_CONVW, I_ALOG, I_DTB, I_NORMO, I_LNG, I_LNB,
       I_WSP, I_BSP, I_WOUTAB, I_WINCD, I_WPOOL, I_PSCALE, I_LAMRE, I_LAMIM, I_LOGDT, I_BRE, I_BIM, I_CRE, I_CIM, I_DSKIP, I_WGLU, I_BGLU, I_WOUTCD, I_WUP, I_WDOWN, I_WPROJ, I_WGATE };

struct Params { const float* in[NIN]; float* out; unsigned char* ws; };

__device__ __forceinline__ float bf2f(bf16_t v) { return __uint_as_float(((unsigned)v) << 16); }
__device__ __forceinline__ unsigned pk2(float lo, float hi) { unsigned r; asm volatile("v_cvt_pk_bf16_f32 %0, %1, %2" : "=v"(r) : "v"(lo), "v"(hi)); return r; }
__device__ __forceinline__ bf16_t f2bf(float f) { return (bf16_t)(pk2(f, 0.f) & 0xffffu); }
__device__ __forceinline__ float sigmoidf_(float x) { return 1.0f / (1.0f + __expf(-x)); }
__device__ __forceinline__ float siluf_(float x) { return x / (1.0f + __expf(-x)); }
__device__ __forceinline__ float geluf_(float x) { const float y = 1.5957691216f * (x + 0.044715f * x * x * x); return x / (1.0f + __expf(-y)); }
template <int CTRL> __device__ __forceinline__ float dpp_f(float x) { return __builtin_bit_cast(float, __builtin_amdgcn_mov_dpp(__builtin_bit_cast(int, x), CTRL, 0xf, 0xf, true)); }
__device__ __forceinline__ float row16_sum(float v) { v += dpp_f<0xB1>(v); v += dpp_f<0x4E>(v); v += dpp_f<0x141>(v); v += dpp_f<0x140>(v); return v; }
__device__ __forceinline__ float rdlane(float v, int l) { return __builtin_bit_cast(float, __builtin_amdgcn_readlane(__builtin_bit_cast(int, v), l)); }
__device__ __forceinline__ float wave_sum(float v) { v = row16_sum(v); return (rdlane(v, 0) + rdlane(v, 16)) + (rdlane(v, 32) + rdlane(v, 48)); }
__device__ __forceinline__ float shfl_xor_l(float v, int lane, int m) { return __builtin_bit_cast(float, __builtin_amdgcn_ds_bpermute((lane ^ m) << 2, __builtin_bit_cast(int, v))); }
__device__ __forceinline__ float rstd_of(const float* ss, int row) { return rsqrtf(ss[row] * (1.0f / 1024.0f) + EPSF); }

#define EPI_LOOP_ROWS for (int ai = 0; ai < 2; ++ai) for (int m = 0; m < 4; ++m)
#define EPI_LOOP_COLS for (int bj = 0; bj < 2; ++bj) for (int n = 0; n < 2; ++n)

struct EpiZ {
    bf16_t* Z; int ldz; const float* ss;
    __device__ __forceinline__ void operator()(const f32x4 (&acc)[2][2][4][2], const Unit& u, int wr, int wc, int fr, int fq) const {
        const int row0 = u.pm * 256 + wr * 64 + fr, col0 = u.pn * 256 + wc * 32 + 4 * fq;
#pragma unroll
        EPI_LOOP_ROWS { const int row = row0 + ai * 128 + m * 16; const float rs = rstd_of(ss, row); bf16_t* rp = Z + (size_t)row * ldz + col0;
#pragma unroll
            EPI_LOOP_COLS { const f32x4 v = acc[ai][bj][m][n] * rs; u32x2 w; w.x = pk2(v[0], v[1]); w.y = pk2(v[2], v[3]); *(u32x2*)(rp + bj * 128 + n * 16) = w; } }
    }
};
struct EpiZ1 {
    float* Z; const float* ss;
    __device__ __forceinline__ void operator()(const f32x4 (&acc)[2][2][4][2], const Unit& u, int wr, int wc, int fr, int fq) const {
        const int row0 = u.pm * 256 + wr * 64 + fr, col0 = u.pn * 256 + wc * 32 + 4 * fq;
#pragma unroll
        EPI_LOOP_ROWS { const int row = row0 + ai * 128 + m * 16; const float rs = rstd_of(ss, row); float* rp = Z + (size_t)row * 1024 + col0;
#pragma unroll
            EPI_LOOP_COLS { *(f32x4*)(rp + bj * 128 + n * 16) = acc[ai][bj][m][n] * rs; } }
    }
};
struct EpiUp {
    bf16_t* Hd; const float* ss;
    __device__ __forceinline__ void operator()(const f32x4 (&acc)[2][2][4][2], const Unit& u, int wr, int wc, int fr, int fq) const {
        const int row0 = u.pm * 256 + wr * 64 + fr, col0 = u.pn * 256 + wc * 32 + 4 * fq;
#pragma unroll
        EPI_LOOP_ROWS { const int row = row0 + ai * 128 + m * 16; const float rs = rstd_of(ss, row); bf16_t* rp = Hd + (size_t)row * DFF + col0;
#pragma unroll
            EPI_LOOP_COLS { f32x4 v = acc[ai][bj][m][n] * rs;
#pragma unroll
                for (int j = 0; j < 4; ++j) { const float r = fmaxf(v[j], 0.f); v[j] = r * r; }
                u32x2 w; w.x = pk2(v[0], v[1]); w.y = pk2(v[2], v[3]); *(u32x2*)(rp + bj * 128 + n * 16) = w; } }
    }
};
struct EpiRes {
    const float* resP; const float* resS; float* H; bf16_t* HB; float* ssout;
    __device__ __forceinline__ void operator()(const f32x4 (&acc)[2][2][4][2], const Unit& u, int wr, int wc, int fr, int fq) const {
        const int row0 = u.pm * 256 + wr * 64 + fr, col0 = u.pn * 256 + wc * 32 + 4 * fq;
#pragma unroll
        EPI_LOOP_ROWS { const int row = row0 + ai * 128 + m * 16;
            const float* rr = (row < MP ? resP + (size_t)row * 1024 : resS + (size_t)(row - MP) * 1024) + col0;
            float* hp = H + (size_t)row * 1024 + col0; bf16_t* bp = HB + (size_t)row * 1024 + col0; float s = 0.f;
#pragma unroll
            EPI_LOOP_COLS { const int co = bj * 128 + n * 16; const f32x4 v = *(const f32x4*)(rr + co) + acc[ai][bj][m][n];
                *(f32x4*)(hp + co) = v; u32x2 w; w.x = pk2(v[0], v[1]); w.y = pk2(v[2], v[3]); *(u32x2*)(bp + co) = w;
                s += (v[0] * v[0] + v[1] * v[1]) + (v[2] * v[2] + v[3] * v[3]); }
            s += shfl_xor_l(s, fq * 16 + fr, 16); s += shfl_xor_l(s, fq * 16 + fr, 32);
            if (fq == 0) atomicAdd(ssout + row, s); }
    }
};
struct EpiGate {
    f32x4* St; const float* ss;
    __device__ __forceinline__ void operator()(const f32x4 (&acc)[2][2][4][2], const Unit& u, int wr, int wc, int fr, int fq) const {
        const int row0 = u.pm * 256 + wr * 64 + fr; const size_t ub = ((size_t)(u.pm * 4 + u.pn) * 32) * 512 + (wr * 4 + wc) * 64 + fq * 16 + fr;
#pragma unroll
        EPI_LOOP_ROWS { const int row = row0 + ai * 128 + m * 16; const float rs = rstd_of(ss, row);
#pragma unroll
            EPI_LOOP_COLS { f32x4 v = acc[ai][bj][m][n] * rs;
#pragma unroll
                for (int j = 0; j < 4; ++j) v[j] = sigmoidf_(v[j]);
                St[ub + (size_t)(((ai * 2 + bj) * 4 + m) * 2 + n) * 512] = v; } }
    }
};
struct EpiProj {
    const f32x4* St; float* H; bf16_t* HB; float* ssout;
    __device__ __forceinline__ void operator()(const f32x4 (&acc)[2][2][4][2], const Unit& u, int wr, int wc, int fr, int fq) const {
        const int row0 = u.pm * 256 + wr * 64 + fr, col0 = u.pn * 256 + wc * 32 + 4 * fq; const size_t ub = ((size_t)(u.pm * 4 + u.pn) * 32) * 512 + (wr * 4 + wc) * 64 + fq * 16 + fr;
#pragma unroll
        EPI_LOOP_ROWS { const int row = row0 + ai * 128 + m * 16;
            float* hp = H + (size_t)row * 1024 + col0; bf16_t* bp = HB + (size_t)row * 1024 + col0; float s = 0.f;
#pragma unroll
            EPI_LOOP_COLS { const int co = bj * 128 + n * 16; const f32x4 g = St[ub + (size_t)(((ai * 2 + bj) * 4 + m) * 2 + n) * 512];
                const f32x4 v = *(const f32x4*)(hp + co) + acc[ai][bj][m][n] * g;
                *(f32x4*)(hp + co) = v; u32x2 w; w.x = pk2(v[0], v[1]); w.y = pk2(v[2], v[3]); *(u32x2*)(bp + co) = w;
                s += (v[0] * v[0] + v[1] * v[1]) + (v[2] * v[2] + v[3] * v[3]); }
            s += shfl_xor_l(s, fq * 16 + fr, 16); s += shfl_xor_l(s, fq * 16 + fr, 32);
            if (fq == 0) atomicAdd(ssout + row, s); }
    }
};
struct EpiGlu {
    const bf16_t* YG; const float* bg; bf16_t* Mix;
    __device__ __forceinline__ void operator()(const f32x4 (&acc)[2][2][4][2], const Unit& u, int wr, int wc, int fr, int fq) const {
        const int row0 = u.pm * 256 + wr * 64 + fr, col0 = u.pn * 256 + wc * 32 + 4 * fq;
#pragma unroll
        EPI_LOOP_ROWS { const int row = row0 + ai * 128 + m * 16;
#pragma unroll
            EPI_LOOP_COLS { const int col = col0 + bj * 128 + n * 16; const u32x2 yv = *(const u32x2*)(YG + (size_t)row * 512 + col); const f32x4 b = *(const f32x4*)(bg + col);
                const f32x4 a = acc[ai][bj][m][n] + b; f32x4 y; y[0] = __uint_as_float(yv.x << 16); y[1] = __uint_as_float(yv.x & 0xffff0000u); y[2] = __uint_as_float(yv.y << 16); y[3] = __uint_as_float(yv.y & 0xffff0000u);
                f32x4 v;
#pragma unroll
                for (int j = 0; j < 4; ++j) v[j] = y[j] * sigmoidf_(a[j]);
                u32x2 w; w.x = pk2(v[0], v[1]); w.y = pk2(v[2], v[3]); *(u32x2*)(Mix + (size_t)row * 1024 + 512 + col) = w; } }
    }
};

template <class Epi>
__device__ __forceinline__ void run_gemm(int wv, PG8_LAS unsigned char* lds, const bf16_t* A, const bf16_t* Bt, int M, int N, int K, const Epi& E) {
    pg8::StaticOrder S; S.init(M, N, (int)gridDim.x, (int)blockIdx.x);
    pg8::Gemm g{A, Bt, M, N, K};
    pg8::gemm_phase<Epi, pg8::StaticOrder>(wv, lds, g, S, E);
}

struct SrcPlain { const float* W; const float* g; int N;
    __device__ __forceinline__ float operator()(int k, int n) const { const float w = W[(size_t)k * N + n]; return g ? w * g[k] : w; } };
struct SrcOutCd { const float* W; const float* wp; const float* sc;
    __device__ __forceinline__ float operator()(int k, int n) const {
        if (k >= 512) return W[(size_t)k * 1024 + n];
        const int gi = k >> 7, i = k & 127; const float* wr_ = wp + ((size_t)gi * 128 + i) * 128; const float* s = sc + gi * 128; const float* wc_ = W + (size_t)(gi * 128) * 1024 + n;
        float a = 0.f;
        for (int j = 0; j < 128; ++j) a += wr_[j] * s[j] * wc_[(size_t)j * 1024];
        return a; } };

template <class F>
__device__ void conv_weight(int wv, float* tile, const F& src, bf16_t* dst, int K, int N, int Npad, int& tcount) {
    const int nkt = K / 64, nnt = Npad / 64, tot = nkt * nnt, tid = opaque_tid(wv), nb = gridDim.x, bid = blockIdx.x;
    for (int t = 0; t < tot; ++t) {
        if ((tcount + t) % nb != bid) continue;
        const int k0 = (t % nkt) * 64, n0 = (t / nkt) * 64;
        __syncthreads();
#pragma unroll
        for (int i = 0; i < 8; ++i) { const int e = tid + i * 512, ik = e >> 6, jn = e & 63; tile[ik * 65 + jn] = (n0 + jn < N) ? src(k0 + ik, n0 + jn) : 0.f; }
        __syncthreads();
#pragma unroll
        for (int i = 0; i < 4; ++i) { const int e = tid + i * 512, jn = e >> 5, ik = (e & 31) * 2;
            *(unsigned*)(dst + (size_t)(n0 + jn) * K + k0 + ik) = pk2(tile[ik * 65 + jn], tile[(ik + 1) * 65 + jn]); }
    }
    tcount += tot;
}

__device__ void phase0(int wv, const Params& p, float* smem) {
    bf16_t* WB = (bf16_t*)(p.ws + WS_WB);
    int tc = 0;
    conv_weight(wv, smem, SrcPlain{p.in[I_WINAB], p.in[I_NMIX], 3080}, WB + WO_IN_AB, 1024, 3080, LDZ, tc);
    conv_weight(wv, smem, SrcPlain{p.in[I_WOUTAB], nullptr, 1024}, WB + WO_OUT_AB, 1024, 1024, 1024, tc);
    conv_weight(wv, smem, SrcPlain{p.in[I_WUP], p.in[I_NFFN], 4096}, WB + WO_UP0, 1024, 4096, 4096, tc);
    conv_weight(wv, smem, SrcPlain{p.in[I_WDOWN], nullptr, 1024}, WB + WO_DOWN0, 4096, 1024, 1024, tc);
    conv_weight(wv, smem, SrcPlain{p.in[I_WGATE], p.in[I_NPE], 1024}, WB + WO_GATE0, 1024, 1024, 1024, tc);
    conv_weight(wv, smem, SrcPlain{p.in[I_WPROJ], nullptr, 1024}, WB + WO_PROJ0, 256, 1024, 1024, tc);
    conv_weight(wv, smem, SrcPlain{p.in[I_WINCD], p.in[I_NMIX] + 1024, 1024}, WB + WO_IN_CD, 1024, 1024, 1024, tc);
    conv_weight(wv, smem, SrcPlain{p.in[I_WGLU], nullptr, 512}, WB + WO_GLU, 512, 512, 512, tc);
    conv_weight(wv, smem, SrcOutCd{p.in[I_WOUTCD], p.in[I_WPOOL], p.in[I_PSCALE]}, WB + WO_OUT_CD, 1024, 1024, 1024, tc);
    conv_weight(wv, smem, SrcPlain{p.in[I_WUP] + (size_t)1024 * 4096, p.in[I_NFFN] + 1024, 4096}, WB + WO_UP1, 1024, 4096, 4096, tc);
    conv_weight(wv, smem, SrcPlain{p.in[I_WDOWN] + (size_t)4096 * 1024, nullptr, 1024}, WB + WO_DOWN1, 4096, 1024, 1024, tc);
    conv_weight(wv, smem, SrcPlain{p.in[I_WGATE] + (size_t)1024 * 1024, p.in[I_NPE] + 1024, 1024}, WB + WO_GATE1, 1024, 1024, 1024, tc);
    conv_weight(wv, smem, SrcPlain{p.in[I_WPROJ] + (size_t)256 * 1024, nullptr, 1024}, WB + WO_PROJ1, 256, 1024, 1024, tc);
    const int tid0 = opaque_tid(wv), lane = tid0 & 63, gw = blockIdx.x * 8 + (tid0 >> 6), nw = gridDim.x * 8;
    bf16_t* X = (bf16_t*)(p.ws + WS_X); float* ss = (float*)(p.ws + WS_SS);
    for (int row = gw; row < MROWS; row += nw) {
        const float* xr = row < MP ? p.in[I_XP] + (size_t)row * 1024 : p.in[I_XS] + (size_t)(row - MP) * 1024;
        float s = 0.f;
#pragma unroll
        for (int i = 0; i < 4; ++i) { const f32x4 v = *(const f32x4*)(xr + (i * 64 + lane) * 4); s += (v[0] * v[0] + v[1] * v[1]) + (v[2] * v[2] + v[3] * v[3]);
            u32x2 w; w.x = pk2(v[0], v[1]); w.y = pk2(v[2], v[3]); *(u32x2*)(X + (size_t)row * 1024 + (i * 64 + lane) * 4) = w; }
        s = wave_sum(s);
        if (lane == 0) ss[row] = s;
    }
    for (int i = blockIdx.x * 512 + tid0; i < 6 * MROWS; i += gridDim.x * 512) ss[MROWS + i] = 0.f;
}

struct DRaw { u32x4 qk[7]; u32x4 v[4]; unsigned m; };
constexpr int DBUF_F = 32 * 128 * 2 + 32 * 16 + 32 * 4;
__device__ __forceinline__ void bf8_to_f(const u32x4 r, float (&x)[8]) {
#pragma unroll
    for (int i = 0; i < 4; ++i) { x[2 * i] = __uint_as_float(r[i] << 16); x[2 * i + 1] = __uint_as_float(r[i] & 0xffff0000u); } }

__device__ void delta_prompt_item(int wv, const Params& p, float* smem, int b, int h, int col0) {
    const int tid = opaque_tid(wv), lane = tid & 63, wid = __builtin_amdgcn_readfirstlane(tid >> 6);
    const int row0 = b * 2048;
    const bf16_t* Z = (const bf16_t*)(p.ws + WS_BIG);
    float* ORAW = (float*)(p.ws + WS_X);
    const float* cw = p.in[I_CONVW];
    constexpr int NCH = 64;
    __syncthreads();
    if (wid >= 4) {
        const int pt = tid - 256, cv = pt & 31, tg = pt >> 5;
        const bool isq = cv < 16;
        const int zc0 = isq ? h * 128 + cv * 8 : 512 + h * 128 + (cv - 16) * 8;
        const int cvv = pt & 1, tokv = (pt >> 1) & 31, zcv = 1024 + h * 128 + col0 + cvv * 8;
        float w[4][8], wvv[4][8];
#pragma unroll
        for (int i = 0; i < 4; ++i) {
            const f32x4 a0 = *(const f32x4*)(cw + i * 1536 + zc0), a1 = *(const f32x4*)(cw + i * 1536 + zc0 + 4), b0 = *(const f32x4*)(cw + i * 1536 + zcv), b1 = *(const f32x4*)(cw + i * 1536 + zcv + 4);
#pragma unroll
            for (int e = 0; e < 4; ++e) { w[i][e] = a0[e]; w[i][4 + e] = a1[e]; wvv[i][e] = b0[e]; wvv[i][4 + e] = b1[e]; }
        }
        const float aexp = __expf(p.in[I_ALOG][h]), dtb = p.in[I_DTB][h];
        auto issue = [&](int ch, DRaw& R) {
            const int t0 = ch * 32;
#pragma unroll
            for (int r = 0; r < 7; ++r) { const int tp = t0 + tg * 4 - 3 + r; R.qk[r] = tp >= 0 ? *(const u32x4*)(Z + (size_t)(row0 + tp) * LDZ + zc0) : (u32x4){0u, 0u, 0u, 0u}; }
            if (pt < 64) {
#pragma unroll
                for (int i = 0; i < 4; ++i) { const int tp = t0 + tokv - 3 + i; R.v[i] = tp >= 0 ? *(const u32x4*)(Z + (size_t)(row0 + tp) * LDZ + zcv) : (u32x4){0u, 0u, 0u, 0u}; }
            } else if (pt < 96) { const size_t r = (size_t)(row0 + t0 + pt - 64) * LDZ; R.m = (unsigned)Z[r + 2048 + h] | ((unsigned)Z[r + 2052 + h] << 16); }
        };
        auto process = [&](const DRaw& R, float* buf) {
            float* qs = buf; float* ks = buf + 32 * 128; float* vs = buf + 2 * 32 * 128; float* meta = vs + 32 * 16;
            float x[7][8];
#pragma unroll
            for (int r = 0; r < 7; ++r) bf8_to_f(R.qk[r], x[r]);
            float* dst = (isq ? qs : ks) + (cv & 15) * 8;
#pragma unroll
            for (int j = 0; j < 4; ++j) { float y[8]; float sq = 0.f;
#pragma unroll
                for (int e = 0; e < 8; ++e) { const float a = w[0][e] * x[j][e] + w[1][e] * x[j + 1][e] + w[2][e] * x[j + 2][e] + w[3][e] * x[j + 3][e]; y[e] = siluf_(a); sq += y[e] * y[e]; }
                sq = row16_sum(sq);
                const float sc = rsqrtf(sq + EPSF) * (isq ? 0.08838834764831845f : 1.0f);
                *(f32x4*)(dst + (tg * 4 + j) * 128) = (f32x4){y[0] * sc, y[1] * sc, y[2] * sc, y[3] * sc};
                *(f32x4*)(dst + (tg * 4 + j) * 128 + 4) = (f32x4){y[4] * sc, y[5] * sc, y[6] * sc, y[7] * sc}; }
            if (pt < 64) { float xv[4][8];
#pragma unroll
                for (int i = 0; i < 4; ++i) bf8_to_f(R.v[i], xv[i]);
                float y[8];
#pragma unroll
                for (int e = 0; e < 8; ++e) y[e] = siluf_(wvv[0][e] * xv[0][e] + wvv[1][e] * xv[1][e] + wvv[2][e] * xv[2][e] + wvv[3][e] * xv[3][e]);
                *(f32x4*)(vs + tokv * 16 + cvv * 8) = (f32x4){y[0], y[1], y[2], y[3]}; *(f32x4*)(vs + tokv * 16 + cvv * 8 + 4) = (f32x4){y[4], y[5], y[6], y[7]};
            } else if (pt < 96) { const float zb = __uint_as_float(R.m << 16), za = __uint_as_float(R.m & 0xffff0000u) + dtb; const float sp = za > 20.f ? za : log1pf(__expf(za));
                meta[(pt - 64) * 4] = __expf(-aexp * sp); meta[(pt - 64) * 4 + 1] = sigmoidf_(zb); }
            asm volatile("s_waitcnt lgkmcnt(0)" ::: "memory");
            { const int tok = (wid - 4) * 8 + (lane >> 3), pr = lane & 7; const float* qp = qs + tok * 128 + pr * 16; const float* kp = ks + tok * 128 + pr * 16; float s = 0.f;
#pragma unroll
                for (int i = 0; i < 4; ++i) { const f32x4 a = *(const f32x4*)(qp + i * 4), c = *(const f32x4*)(kp + i * 4); s += (a[0] * c[0] + a[1] * c[1]) + (a[2] * c[2] + a[3] * c[3]); }
                s += dpp_f<0xB1>(s); s += dpp_f<0x4E>(s); s += dpp_f<0x141>(s);
                if (pr == 0) meta[tok * 4 + 2] = s; }
        };
        DRaw R0, R1;
        issue(0, R0); process(R0, smem); issue(1, R1);
        __syncthreads();
        for (int i = 0; i < NCH; i += 2) {
            if (i + 2 < NCH) issue(i + 2, R0);
            process(R1, smem + DBUF_F);
            __syncthreads();
            if (i + 3 < NCH) issue(i + 3, R1);
            if (i + 2 < NCH) process(R0, smem);
            __syncthreads();
        }
    } else {
        const int part = lane & 15, cl = lane >> 4, col = col0 + wid * 4 + cl;
        float S[8];
#pragma unroll
        for (int i = 0; i < 8; ++i) S[i] = 0.f;
        float* op = ORAW + (size_t)row0 * 512 + h * 128 + col;
        __syncthreads();
        for (int i = 0; i < NCH; ++i) {
            const float* buf = smem + (i & 1) * DBUF_F; const float* qs = buf; const float* ks = buf + 32 * 128; const float* vs = buf + 2 * 32 * 128; const float* meta = vs + 32 * 16;
#pragma unroll 4
            for (int tt = 0; tt < 32; ++tt) {
                const f32x4 ka = *(const f32x4*)(ks + tt * 128 + part * 4), kb = *(const f32x4*)(ks + tt * 128 + 64 + part * 4);
                const f32x4 qa = *(const f32x4*)(qs + tt * 128 + part * 4), qb = *(const f32x4*)(qs + tt * 128 + 64 + part * 4);
                const f32x4 mt = *(const f32x4*)(meta + tt * 4); const float v = vs[tt * 16 + wid * 4 + cl];
                float d1 = ((S[0] * ka[0] + S[1] * ka[1]) + (S[2] * ka[2] + S[3] * ka[3])) + ((S[4] * kb[0] + S[5] * kb[1]) + (S[6] * kb[2] + S[7] * kb[3]));
                float d2 = ((S[0] * qa[0] + S[1] * qa[1]) + (S[2] * qa[2] + S[3] * qa[3])) + ((S[4] * qb[0] + S[5] * qb[1]) + (S[6] * qb[2] + S[7] * qb[3]));
                d1 += dpp_f<0xB1>(d1); d2 += dpp_f<0xB1>(d2); d1 += dpp_f<0x4E>(d1); d2 += dpp_f<0x4E>(d2);
                d1 += dpp_f<0x141>(d1); d2 += dpp_f<0x141>(d2); d1 += dpp_f<0x140>(d1); d2 += dpp_f<0x140>(d2);
                const float a = mt[0], uu = mt[1] * (v - a * d1);
#pragma unroll
                for (int e = 0; e < 4; ++e) { S[e] = a * S[e] + ka[e] * uu; S[4 + e] = a * S[4 + e] + kb[e] * uu; }
                if (part == 0) op[(size_t)(i * 32 + tt) * 512] = a * d2 + uu * mt[2];
            }
            __syncthreads();
        }
        float* sp = p.out + O_DELTA_P + ((size_t)(b * 4 + h) * 128) * 128 + col;
#pragma unroll
        for (int i = 0; i < 8; ++i) { const int d = (i >> 2) * 64 + part * 4 + (i & 3); sp[(size_t)d * 128] = S[i]; }
    }
}

__device__ void delta_sample_item(int wv, const Params& p, float* smem, int b, int h) {
    const int tid = opaque_tid(wv), lane = tid & 63, wid = __builtin_amdgcn_readfirstlane(tid >> 6);
    const int row0 = MP + b * 8;
    const bf16_t* Z = (const bf16_t*)(p.ws + WS_BIG);
    float* ORAW = (float*)(p.ws + WS_X);
    const float* cw = p.in[I_CONVW]; const float* sconv = p.in[I_SCONV] + (size_t)b * 3 * 1536;
    float* Ssh = smem; float* qs = smem + 128 * 128; float* ks = qs + 8 * 128; float* vs = ks + 8 * 128; float* meta = vs + 8 * 128;
    const float* sin_ = p.in[I_SDELTA] + (size_t)(b * 4 + h) * 128 * 128;
    __syncthreads();
    f32x4 st[8];
#pragma unroll
    for (int i = 0; i < 8; ++i) st[i] = *(const f32x4*)(sin_ + (size_t)(i * 512 + tid) * 4);
    if (tid < 384) {
        const int tt = tid / 48, cvx = tid - tt * 48; int zc; float* dst;
        if (cvx < 16) { zc = h * 128 + cvx * 8; dst = qs + tt * 128 + cvx * 8; } else if (cvx < 32) { zc = 512 + h * 128 + (cvx - 16) * 8; dst = ks + tt * 128 + (cvx - 16) * 8; } else { zc = 1024 + h * 128 + (cvx - 32) * 8; dst = vs + tt * 128 + (cvx - 32) * 8; }
        float acc[8];
#pragma unroll
        for (int e = 0; e < 8; ++e) acc[e] = 0.f;
#pragma unroll
        for (int i = 0; i < 4; ++i) { const int tp = tt - 3 + i; float x[8];
            if (tp >= 0) { const u32x4 r = *(const u32x4*)(Z + (size_t)(row0 + tp) * LDZ + zc); bf8_to_f(r, x); }
            else { const f32x4 a = *(const f32x4*)(sconv + (tp + 3) * 1536 + zc), c = *(const f32x4*)(sconv + (tp + 3) * 1536 + zc + 4);
#pragma unroll
                for (int e = 0; e < 4; ++e) { x[e] = a[e]; x[4 + e] = c[e]; } }
            const f32x4 w0 = *(const f32x4*)(cw + i * 1536 + zc), w1 = *(const f32x4*)(cw + i * 1536 + zc + 4);
#pragma unroll
            for (int e = 0; e < 4; ++e) { acc[e] += w0[e] * x[e]; acc[4 + e] += w1[e] * x[4 + e]; } }
        *(f32x4*)dst = (f32x4){siluf_(acc[0]), siluf_(acc[1]), siluf_(acc[2]), siluf_(acc[3])}; *(f32x4*)(dst + 4) = (f32x4){siluf_(acc[4]), siluf_(acc[5]), siluf_(acc[6]), siluf_(acc[7])};
    } else if (tid < 392) { const int tt = tid - 384; const size_t r = (size_t)(row0 + tt) * LDZ; const float zb = bf2f(Z[r + 2048 + h]), za = bf2f(Z[r + 2052 + h]) + p.in[I_DTB][h];
        const float sp = za > 20.f ? za : log1pf(__expf(za)); meta[tt * 4] = __expf(-__expf(p.in[I_ALOG][h]) * sp); meta[tt * 4 + 1] = sigmoidf_(zb); }
#pragma unroll
    for (int i = 0; i < 8; ++i) *(f32x4*)(Ssh + (size_t)(i * 512 + tid) * 4) = st[i];
    __syncthreads();
    {
        const int tt = wid; const float q0 = qs[tt * 128 + lane], q1 = qs[tt * 128 + 64 + lane], k0 = ks[tt * 128 + lane], k1 = ks[tt * 128 + 64 + lane];
        const float sq = rsqrtf(wave_sum(q0 * q0 + q1 * q1) + EPSF) * 0.08838834764831845f, sk = rsqrtf(wave_sum(k0 * k0 + k1 * k1) + EPSF);
        const float kq = wave_sum(q0 * k0 + q1 * k1) * sq * sk;
        qs[tt * 128 + lane] = q0 * sq; qs[tt * 128 + 64 + lane] = q1 * sq; ks[tt * 128 + lane] = k0 * sk; ks[tt * 128 + 64 + lane] = k1 * sk;
        if (lane == 0) meta[tt * 4 + 2] = kq;
    }
    __syncthreads();
    const int part = lane & 15, cl = lane >> 4;
    for (int pp = 0; pp < 4; ++pp) {
        const int col = pp * 32 + wid * 4 + cl; float S[8];
#pragma unroll
        for (int i = 0; i < 8; ++i) { const int d = (i >> 2) * 64 + part * 4 + (i & 3); S[i] = Ssh[d * 128 + col]; }
#pragma unroll
        for (int tt = 0; tt < 8; ++tt) {
            const f32x4 ka = *(const f32x4*)(ks + tt * 128 + part * 4), kb = *(const f32x4*)(ks + tt * 128 + 64 + part * 4);
            const f32x4 qa = *(const f32x4*)(qs + tt * 128 + part * 4), qb = *(const f32x4*)(qs + tt * 128 + 64 + part * 4);
            const f32x4 mt = *(const f32x4*)(meta + tt * 4); const float v = vs[tt * 128 + col];
            float d1 = ((S[0] * ka[0] + S[1] * ka[1]) + (S[2] * ka[2] + S[3] * ka[3])) + ((S[4] * kb[0] + S[5] * kb[1]) + (S[6] * kb[2] + S[7] * kb[3]));
            float d2 = ((S[0] * qa[0] + S[1] * qa[1]) + (S[2] * qa[2] + S[3] * qa[3])) + ((S[4] * qb[0] + S[5] * qb[1]) + (S[6] * qb[2] + S[7] * qb[3]));
            d1 = row16_sum(d1); d2 = row16_sum(d2);
            const float a = mt[0], uu = mt[1] * (v - a * d1);
#pragma unroll
            for (int e = 0; e < 4; ++e) { S[e] = a * S[e] + ka[e] * uu; S[4 + e] = a * S[4 + e] + kb[e] * uu; }
            if (part == 0) ORAW[(size_t)(row0 + tt) * 512 + h * 128 + col] = a * d2 + uu * mt[2];
        }
#pragma unroll
        for (int i = 0; i < 8; ++i) { const int d = (i >> 2) * 64 + part * 4 + (i & 3); Ssh[d * 128 + col] = S[i]; }
    }
    __syncthreads();
    float* sout = p.out + O_DELTA_S + (size_t)(b * 4 + h) * 128 * 128;
#pragma unroll
    for (int i = 0; i < 8; ++i) *(f32x4*)(sout + (size_t)(i * 512 + tid) * 4) = *(const f32x4*)(Ssh + (size_t)(i * 512 + tid) * 4);
}

__device__ void phase2a(int wv, const Params& p, float* smem) {
    const int nb = gridDim.x, bid = blockIdx.x;
    for (int it = bid; it < 256; it += nb) { const int bh = it >> 3, sl = it & 7; delta_prompt_item(wv, p, smem, bh >> 2, bh & 3, sl * 16); }
    for (int it = bid; it < 512; it += nb) delta_sample_item(wv, p, smem, it >> 2, it & 3);
}


__device__ void sgu_prompt_item(int wv, const Params& p, float* smem, int b, int nch, int g) {
    const int tid = opaque_tid(wv), lane = tid & 63, wid = tid >> 6;
    const bf16_t* Z = (const bf16_t*)(p.ws + WS_BIG); bf16_t* Mix = (bf16_t*)(p.ws + WS_Y);
    float* vS = smem; float* wS = smem + 128 * 128; float* st = smem + 2 * 128 * 128;
    const int row0 = b * 2048 + nch * 128;
    __syncthreads();
    for (int t = wid; t < 128; t += 8) {
        const u32x4 raw = *(const u32x4*)(Z + (size_t)(row0 + t) * LDZ + 2568 + lane * 8); float x[8];
#pragma unroll
        for (int i = 0; i < 4; ++i) { x[2 * i] = geluf_(__uint_as_float(raw[i] << 16)); x[2 * i + 1] = geluf_(__uint_as_float(raw[i] & 0xffff0000u)); }
        float s = 0.f;
#pragma unroll
        for (int i = 0; i < 8; ++i) s += x[i];
        const float mean = wave_sum(s) * (1.0f / 512.0f); float q = 0.f;
#pragma unroll
        for (int i = 0; i < 8; ++i) { const float d = x[i] - mean; q += d * d; }
        const float var = wave_sum(q) * (1.0f / 512.0f);
        if (lane == 0) { st[t * 2] = mean; st[t * 2 + 1] = rsqrtf(var + EPSF); }
    }
    {
        const float* wsp = p.in[I_WSP] + (size_t)g * 128 * 128;
        for (int idx = tid; idx < 128 * 128; idx += 512) { const int t = idx >> 7, s = idx & 127; wS[idx] = (s <= t) ? wsp[idx] : 0.f; }
    }
    __syncthreads();
    {
        const float* lg = p.in[I_LNG]; const float* lb = p.in[I_LNB];
        for (int idx = tid; idx < 128 * 128; idx += 512) { const int s = idx >> 7, c = idx & 127, ch = g * 128 + c;
            const float x = geluf_(bf2f(Z[(size_t)(row0 + s) * LDZ + 2568 + ch])); const float v = (x - st[s * 2]) * st[s * 2 + 1] * lg[ch] + lb[ch];
            vS[idx] = v;
            if (nch == 15) p.out[O_SGUV_P + ((size_t)b * 128 + s) * 512 + ch] = v; }
    }
    __syncthreads();
    const int c = tid & 127, tq = tid >> 7; const float* bsp = p.in[I_BSP] + g * 128;
    for (int jj = 0; jj < 8; ++jj) {
        const int tb = tq + 4 * jj; float a0 = 0.f, a1 = 0.f, a2 = 0.f, a3 = 0.f;
        for (int s4 = 0; s4 <= 4 * tb; s4 += 4) {
            const float v0 = vS[(s4 + 0) * 128 + c], v1 = vS[(s4 + 1) * 128 + c], v2 = vS[(s4 + 2) * 128 + c], v3 = vS[(s4 + 3) * 128 + c];
            const f32x4 w0 = *(const f32x4*)(wS + (4 * tb + 0) * 128 + s4), w1 = *(const f32x4*)(wS + (4 * tb + 1) * 128 + s4), w2 = *(const f32x4*)(wS + (4 * tb + 2) * 128 + s4), w3 = *(const f32x4*)(wS + (4 * tb + 3) * 128 + s4);
            a0 += w0[0] * v0 + w0[1] * v1 + w0[2] * v2 + w0[3] * v3; a1 += w1[0] * v0 + w1[1] * v1 + w1[2] * v2 + w1[3] * v3;
            a2 += w2[0] * v0 + w2[1] * v1 + w2[2] * v2 + w2[3] * v3; a3 += w3[0] * v0 + w3[1] * v1 + w3[2] * v2 + w3[3] * v3;
        }
        const float accs[4] = {a0, a1, a2, a3};
#pragma unroll
        for (int e = 0; e < 4; ++e) { const int t = 4 * tb + e; const float u = geluf_(bf2f(Z[(size_t)(row0 + t) * LDZ + 2056 + g * 128 + c]));
            Mix[(size_t)(row0 + t) * 1024 + 512 + g * 128 + c] = f2bf(u * (accs[e] + bsp[t])); }
    }
}

__device__ void sgu_sample_item(int wv, const Params& p, float* smem, int b) {
    const int tid = opaque_tid(wv), lane = tid & 63, wid = tid >> 6;
    const bf16_t* Z = (const bf16_t*)(p.ws + WS_BIG); bf16_t* Mix = (bf16_t*)(p.ws + WS_Y);
    float* vS = smem;
    const int row0 = MP + b * 8;
    __syncthreads();
    {   const int t = wid; const u32x4 raw = *(const u32x4*)(Z + (size_t)(row0 + t) * LDZ + 2568 + lane * 8); float x[8];
#pragma unroll
        for (int i = 0; i < 4; ++i) { x[2 * i] = geluf_(__uint_as_float(raw[i] << 16)); x[2 * i + 1] = geluf_(__uint_as_float(raw[i] & 0xffff0000u)); }
        float s = 0.f;
#pragma unroll
        for (int i = 0; i < 8; ++i) s += x[i];
        const float mean = wave_sum(s) * (1.0f / 512.0f); float q = 0.f;
#pragma unroll
        for (int i = 0; i < 8; ++i) { const float d = x[i] - mean; q += d * d; }
        const float rs = rsqrtf(wave_sum(q) * (1.0f / 512.0f) + EPSF);
#pragma unroll
        for (int i = 0; i < 8; ++i) { const int ch = lane * 8 + i; const float v = (x[i] - mean) * rs * p.in[I_LNG][ch] + p.in[I_LNB][ch]; vS[t * 512 + ch] = v; p.out[O_SGUV_S + ((size_t)b * 8 + t) * 512 + ch] = v; }
    }
    __syncthreads();
    const int ch = tid, g = ch >> 7; const float* wsp = p.in[I_WSP] + (size_t)g * 128 * 128; const float* bsp = p.in[I_BSP] + g * 128;
    for (int t = 0; t < 8; ++t) { float a = bsp[t];
        for (int s = 0; s <= t; ++s) a += wsp[t * 128 + s] * vS[s * 512 + ch];
        const float u = geluf_(bf2f(Z[(size_t)(row0 + t) * LDZ + 2056 + ch]));
        Mix[(size_t)(row0 + t) * 1024 + 512 + ch] = f2bf(u * a); }
}

__device__ void phase2b(int wv, const Params& p, float* smem) {
    const int tid = opaque_tid(wv), lane = tid & 63, nb = gridDim.x, bid = blockIdx.x, gw = bid * 8 + (tid >> 6), nw = nb * 8;
    const bf16_t* Z = (const bf16_t*)(p.ws + WS_BIG); bf16_t* Mix = (bf16_t*)(p.ws + WS_Y); const float* ORAW = (const float*)(p.ws + WS_X);
    for (int it = gw; it < MROWS * 4; it += nw) { const int row = it >> 2, h = it & 3, c = h * 128 + lane * 2;
        const float o0 = ORAW[(size_t)row * 512 + c], o1 = ORAW[(size_t)row * 512 + c + 1];
        const float rs = rsqrtf(wave_sum(o0 * o0 + o1 * o1) * (1.0f / 128.0f) + EPSF);
        const unsigned zg = *(const unsigned*)(Z + (size_t)row * LDZ + 1536 + c);
        const float g0 = siluf_(__uint_as_float(zg << 16)), g1 = siluf_(__uint_as_float(zg & 0xffff0000u));
        *(unsigned*)(Mix + (size_t)row * 1024 + c) = pk2(o0 * rs * p.in[I_NORMO][lane * 2] * g0, o1 * rs * p.in[I_NORMO][lane * 2 + 1] * g1); }
    for (int i = bid * 512 + tid; i < 8 * 3 * 1536; i += nb * 512) { const int c = i % 1536, r = (i / 1536) % 3, b = i / (3 * 1536); p.out[O_CONV_P + i] = bf2f(Z[(size_t)(b * 2048 + 2045 + r) * LDZ + c]); }
    for (int i = bid * 512 + tid; i < 128 * 3 * 1536; i += nb * 512) { const int c = i % 1536, r = (i / 1536) % 3, b = i / (3 * 1536); p.out[O_CONV_S + i] = bf2f(Z[(size_t)(MP + b * 8 + 5 + r) * LDZ + c]); }
    for (int it = bid; it < 512; it += nb) sgu_prompt_item(wv, p, smem, it >> 6, (it >> 2) & 15, it & 3);
    for (int it = bid; it < 128; it += nb) sgu_sample_item(wv, p, smem, it);
}

__device__ void s5_item(const Params& p, float* wl  , bool sample, int b, int g) {
    const int lane = lane_id_(), lr16 = lane & 15, lq = lane >> 4;
    const float* Z1 = (const float*)(p.ws + WS_BIG + BIG_Z1); bf16_t* YG = (bf16_t*)(p.ws + WS_BIG + BIG_YG);
    float* buL = wl; float* sL = wl + 16 * 132;
    const int T = sample ? 8 : 2048, row0 = sample ? MP + b * 8 : b * 2048;
    const float dt = __expf(p.in[I_LOGDT][g]);
    const float* lamre = p.in[I_LAMRE] + g * 64; const float* lamim = p.in[I_LAMIM] + g * 64;
    float lbr, lbi;
    { const float x = lamre[lane] * dt, y = lamim[lane] * dt, ex = __expf(x); float sn, cs; sincosf(y, &sn, &cs); lbr = ex * cs; lbi = ex * sn; }
    float sr = 0.f, si = 0.f;
    if (sample) { sr = p.in[I_S5RE][((size_t)b * 32 + g) * 64 + lane]; si = p.in[I_S5IM][((size_t)b * 32 + g) * 64 + lane]; }
    bf16x8 bfr[8];
    {
        float fre[4], fim[4];
#pragma unroll
        for (int j = 0; j < 4; ++j) { const int nn = j * 16 + lr16; const float lr = lamre[nn], li = lamim[nn], x = lr * dt, y = li * dt; float sn, cs; sincosf(y, &sn, &cs);
            const float ex = __expf(x), em = expm1f(x), sh = sinf(0.5f * y); const float re1 = em * cs - 2.f * sh * sh, im1 = ex * sn, den = 1.0f / (lr * lr + li * li);
            fre[j] = (re1 * lr + im1 * li) * den; fim[j] = (im1 * lr - re1 * li) * den; }
#pragma unroll
        for (int j = 0; j < 8; ++j) { const int nn = (j & 3) * 16 + lr16; const bool im = j >= 4; unsigned w[4] = {0u, 0u, 0u, 0u};
            if (lq < 2) { const float* br = p.in[I_BRE] + ((size_t)g * 64 + nn) * 16 + lq * 8; const float* bi = p.in[I_BIM] + ((size_t)g * 64 + nn) * 16 + lq * 8; float v[8];
#pragma unroll
                for (int i = 0; i < 8; ++i) v[i] = im ? (fre[j & 3] * bi[i] + fim[j & 3] * br[i]) : (fre[j & 3] * br[i] - fim[j & 3] * bi[i]);
#pragma unroll
                for (int i = 0; i < 4; ++i) w[i] = pk2(v[2 * i], v[2 * i + 1]); }
            bfr[j] = __builtin_bit_cast(bf16x8, (u32x4){w[0], w[1], w[2], w[3]}); }
    }
    bf16x8 cfr[4];
#pragma unroll
    for (int kk = 0; kk < 4; ++kk) { const int n0 = kk * 32 + lq * 8; const float* src = (n0 < 64 ? p.in[I_CRE] : p.in[I_CIM]) + ((size_t)g * 16 + lr16) * 64 + (n0 & 63); const float sg = n0 < 64 ? 1.f : -1.f; unsigned w[4];
#pragma unroll
        for (int i = 0; i < 4; ++i) w[i] = pk2(sg * src[2 * i], sg * src[2 * i + 1]);
        cfr[kk] = __builtin_bit_cast(bf16x8, (u32x4){w[0], w[1], w[2], w[3]}); }
    const float dsk = p.in[I_DSKIP][g * 16 + lr16];
    for (int t0 = 0; t0 < T; t0 += 16) {
        const int nv = (T - t0) < 16 ? (T - t0) : 16;
        bf16x8 afr; { unsigned w[4] = {0u, 0u, 0u, 0u};
            if (lq < 2 && lr16 < nv) { const float* up = Z1 + (size_t)(row0 + t0 + lr16) * 1024 + 512 + g * 16 + lq * 8; const f32x4 a = *(const f32x4*)up, c4 = *(const f32x4*)(up + 4);
                w[0] = pk2(a[0], a[1]); w[1] = pk2(a[2], a[3]); w[2] = pk2(c4[0], c4[1]); w[3] = pk2(c4[2], c4[3]); }
            afr = __builtin_bit_cast(bf16x8, (u32x4){w[0], w[1], w[2], w[3]}); }
#pragma unroll
        for (int j = 0; j < 8; ++j) { f32x4 acc = {0.f, 0.f, 0.f, 0.f}; acc = __builtin_amdgcn_mfma_f32_16x16x32_bf16(afr, bfr[j], acc, 0, 0, 0);
#pragma unroll
            for (int jj = 0; jj < 4; ++jj) buL[(lq * 4 + jj) * 132 + j * 16 + lr16] = acc[jj]; }
        asm volatile("s_waitcnt lgkmcnt(0)" ::: "memory");
        for (int tt = 0; tt < nv; ++tt) { const float bur = buL[tt * 132 + lane], bui = buL[tt * 132 + 64 + lane];
            const float nr = lbr * sr - lbi * si + bur, ni = lbr * si + lbi * sr + bui; sr = nr; si = ni;
            sL[tt * 132 + lane] = nr; sL[tt * 132 + 64 + lane] = ni; }
        asm volatile("s_waitcnt lgkmcnt(0)" ::: "memory");
        f32x4 yacc = {0.f, 0.f, 0.f, 0.f};
#pragma unroll
        for (int kk = 0; kk < 4; ++kk) { const float* sp = sL + lr16 * 132 + kk * 32 + lq * 8; const f32x4 a = *(const f32x4*)sp, c4 = *(const f32x4*)(sp + 4);
            const bf16x8 sfr = __builtin_bit_cast(bf16x8, (u32x4){pk2(a[0], a[1]), pk2(a[2], a[3]), pk2(c4[0], c4[1]), pk2(c4[2], c4[3])});
            yacc = __builtin_amdgcn_mfma_f32_16x16x32_bf16(sfr, cfr[kk], yacc, 0, 0, 0); }
#pragma unroll
        for (int jj = 0; jj < 4; ++jj) { const int tok = lq * 4 + jj;
            if (tok < nv) { const size_t r = (size_t)(row0 + t0 + tok); const float u = Z1[r * 1024 + 512 + g * 16 + lr16];
                YG[r * 512 + g * 16 + lr16] = f2bf(geluf_(yacc[jj] + dsk * u)); } }
        asm volatile("s_waitcnt lgkmcnt(0)" ::: "memory");
    }
    float* ore = p.out + (sample ? O_S5RE_S : O_S5RE_P) + ((size_t)b * 32 + g) * 64; float* oim = p.out + (sample ? O_S5IM_S : O_S5IM_P) + ((size_t)b * 32 + g) * 64;
    ore[lane] = sr; oim[lane] = si;
}

__device__ void phase8a(int wv, const Params& p, float* smem) {
    const int tid = opaque_tid(wv), lane = tid & 63, wid = __builtin_amdgcn_readfirstlane(tid >> 6), nb = gridDim.x, bid = blockIdx.x;
    float* wl = smem + wid * (2 * 16 * 132);
    const float* Z1 = (const float*)(p.ws + WS_BIG + BIG_Z1); bf16_t* Mix = (bf16_t*)(p.ws + WS_Y);
    if (wid == 0) { for (int it = bid; it < 256; it += nb) s5_item(p, wl, false, it >> 5, it & 31); return; }
    const int hw = bid * 7 + (wid - 1), nh = nb * 7;
    for (int it = hw; it < 4096; it += nh) s5_item(p, wl, true, it >> 5, it & 31);
    for (int it = hw; it < MROWS * 8; it += nh) { const int row = it >> 3, ck = it & 7, c = ck * 64 + lane, gi = ck >> 1, win = 2 << gi;
        const bool smp = row >= MP; const int b = smp ? (row - MP) >> 3 : row >> 11, t = smp ? (row - MP) & 7 : row & 2047, rbase = row - t;
        float s = 0.f;
        for (int i = 0; i < win; ++i) { const int tp = t - i; float x;
            if (tp >= 0) x = Z1[(size_t)(rbase + tp) * 1024 + c]; else x = smp ? p.in[I_SPOOL][((size_t)b * 15 + 15 + tp) * 512 + c] : 0.f;
            s += x; }
        const float cnt = smp ? (float)win : (float)((t + 1) < win ? (t + 1) : win);
        Mix[(size_t)row * 1024 + c] = f2bf(s / cnt - Z1[(size_t)row * 1024 + c]); }
    for (int i = hw * 64 + lane; i < 8 * 15 * 512; i += nh * 64) { const int c = i & 511, r = (i >> 9) % 15, b = i / (15 * 512); p.out[O_POOL_P + i] = Z1[(size_t)(b * 2048 + 2033 + r) * 1024 + c]; }
    for (int i = hw * 64 + lane; i < 128 * 15 * 512; i += nh * 64) { const int c = i & 511, r = (i >> 9) % 15, b = i / (15 * 512);
        p.out[O_POOL_S + i] = r < 7 ? p.in[I_SPOOL][((size_t)b * 15 + r + 8) * 512 + c] : Z1[(size_t)(MP + b * 8 + r - 7) * 1024 + c]; }
}

__device__ void convert_p(int wv, const Params& p, int layer, bf16_t* dst) {
    const float* pp = p.in[I_PP] + (size_t)layer * MP * 256; const float* ps = p.in[I_PS] + (size_t)layer * 1024 * 256;
    for (size_t i = (size_t)blockIdx.x * 512 + opaque_tid(wv); i < (size_t)MROWS * 64; i += (size_t)gridDim.x * 512) {
        const size_t e = i * 4; const f32x4 v = e < (size_t)MP * 256 ? *(const f32x4*)(pp + e) : *(const f32x4*)(ps + (e - (size_t)MP * 256));
        u32x2 w; w.x = pk2(v[0], v[1]); w.y = pk2(v[2], v[3]); *(u32x2*)(dst + e) = w; }
}

__global__ void __launch_bounds__(512) fwd_megakernel(Params p) {
    extern __shared__ __attribute__((aligned(16))) unsigned char dynlds[];
    cg::grid_group grid = cg::this_grid();
    PG8_LAS unsigned char* lds = (PG8_LAS unsigned char*)dynlds;
    float* smem = (float*)dynlds;
    unsigned char* ws = p.ws;
    bf16_t* WB = (bf16_t*)(ws + WS_WB); bf16_t* X = (bf16_t*)(ws + WS_X); bf16_t* Y = (bf16_t*)(ws + WS_Y); float* ss = (float*)(ws + WS_SS);
    bf16_t* BIGb = (bf16_t*)(ws + WS_BIG);
    float* H = p.out + O_Y;

    const int wv = __builtin_amdgcn_readfirstlane((int)threadIdx.x >> 6);
    phase0(wv, p, smem);
    grid.sync();
    run_gemm(wv, lds, X, WB + WO_IN_AB, MROWS, LDZ, 1024, EpiZ{BIGb, LDZ, ss});
    grid.sync();
    phase2a(wv, p, smem);
    grid.sync();
    phase2b(wv, p, smem);
    grid.sync();
    run_gemm(wv, lds, Y, WB + WO_OUT_AB, MROWS, 1024, 1024, EpiRes{p.in[I_XP], p.in[I_XS], H, X, ss + 1 * MROWS});
    grid.sync();
    run_gemm(wv, lds, X, WB + WO_UP0, MROWS, DFF, 1024, EpiUp{BIGb, ss + 1 * MROWS});
    grid.sync();
    run_gemm(wv, lds, BIGb, WB + WO_DOWN0, MROWS, 1024, DFF, EpiRes{H, H + (size_t)MP * 1024, H, Y, ss + 2 * MROWS});
    convert_p(wv, p, 0, WB + WO_IN_AB);
    grid.sync();
    run_gemm(wv, lds, Y, WB + WO_GATE0, MROWS, 1024, 1024, EpiGate{(f32x4*)(ws + WS_BIG), ss + 2 * MROWS});
    run_gemm(wv, lds, WB + WO_IN_AB, WB + WO_PROJ0, MROWS, 1024, 256, EpiProj{(const f32x4*)(ws + WS_BIG), H, X, ss + 3 * MROWS});
    grid.sync();
    run_gemm(wv, lds, X, WB + WO_IN_CD, MROWS, 1024, 1024, EpiZ1{(float*)(ws + WS_BIG + BIG_Z1), ss + 3 * MROWS});
    grid.sync();
    phase8a(wv, p, smem);
    grid.sync();
    run_gemm(wv, lds, (const bf16_t*)(ws + WS_BIG + BIG_YG), WB + WO_GLU, MROWS, 512, 512, EpiGlu{(const bf16_t*)(ws + WS_BIG + BIG_YG), p.in[I_BGLU], Y});
    grid.sync();
    run_gemm(wv, lds, Y, WB + WO_OUT_CD, MROWS, 1024, 1024, EpiRes{H, H + (size_t)MP * 1024, H, X, ss + 4 * MROWS});
    grid.sync();
    run_gemm(wv, lds, X, WB + WO_UP1, MROWS, DFF, 1024, EpiUp{BIGb, ss + 4 * MROWS});
    grid.sync();
    run_gemm(wv, lds, BIGb, WB + WO_DOWN1, MROWS, 1024, DFF, EpiRes{H, H + (size_t)MP * 1024, H, Y, ss + 5 * MROWS});
    convert_p(wv, p, 1, WB + WO_UP0);
    grid.sync();
    run_gemm(wv, lds, Y, WB + WO_GATE1, MROWS, 1024, 1024, EpiGate{(f32x4*)(ws + WS_BIG), ss + 5 * MROWS});
    run_gemm(wv, lds, WB + WO_UP0, WB + WO_PROJ1, MROWS, 1024, 256, EpiProj{(const f32x4*)(ws + WS_BIG), H, X, ss + 6 * MROWS});
    grid.sync();
    {
        const int tidf = opaque_tid(wv), lane = tidf & 63, gw = blockIdx.x * 8 + (tidf >> 6), nw = gridDim.x * 8; const float* gf = p.in[I_NFINAL]; const float* s6 = ss + 6 * MROWS;
        for (int row = gw; row < MROWS; row += nw) { const float rs = rstd_of(s6, row); float* hr = H + (size_t)row * 1024;
#pragma unroll
            for (int i = 0; i < 4; ++i) { const int c = (i * 64 + lane) * 4; *(f32x4*)(hr + c) = *(const f32x4*)(hr + c) * rs * *(const f32x4*)(gf + c); } }
    }
}

extern "C" void kernel_launch(void* const* d_in, const int* in_sizes, int n_in, void* d_out, int out_size, void* d_ws, size_t ws_size, hipStream_t stream) {
    static int grid_blocks = 0;
    if (grid_blocks == 0) {
        if (n_in != NIN || (size_t)out_size != O_END || ws_size < WS_END) { fprintf(stderr, "kernel_launch: unexpected shapes n_in %d out %d ws %zu\n", n_in, out_size, ws_size); grid_blocks = -1; return; }
        int dev = 0, cus = 0, per_cu = 0;
        hipGetDevice(&dev);
        hipDeviceGetAttribute(&cus, hipDeviceAttributeMultiprocessorCount, dev);
        if (hipFuncSetAttribute((const void*)fwd_megakernel, hipFuncAttributeMaxDynamicSharedMemorySize, LDS_BYTES) != hipSuccess) { fprintf(stderr, "kernel_launch: hipFuncSetAttribute failed\n"); grid_blocks = -1; return; }
        if (hipOccupancyMaxActiveBlocksPerMultiprocessor(&per_cu, (const void*)fwd_megakernel, 512, LDS_BYTES) != hipSuccess || per_cu < 1) { fprintf(stderr, "kernel_launch: occupancy query failed (%d)\n", per_cu); per_cu = 1; (void)hipGetLastError(); }
        grid_blocks = cus * per_cu;
    }
    if (grid_blocks < 0) return;
    Params p{};
    for (int i = 0; i < NIN; ++i) p.in[i] = (const float*)d_in[i];
    p.out = (float*)d_out; p.ws = (unsigned char*)d_ws;
    void* args[] = {&p};
    hipError_t e = hipLaunchCooperativeKernel((const void*)fwd_megakernel, dim3(grid_blocks), dim3(512), args, LDS_BYTES, stream);
    if (e != hipSuccess) fprintf(stderr, "cooperative launch failed: %s (grid %d)\n", hipGetErrorString(e), grid_blocks);
}
```

```cpp
#include <hip/hip_runtime.h>
#include <hip/hip_cooperative_groups.h>
#include <cstdio>
namespace cg = cooperative_groups;

__device__ __forceinline__ int lane_id_() { return (int)__builtin_amdgcn_mbcnt_hi(~0u, __builtin_amdgcn_mbcnt_lo(~0u, 0u)); }
__device__ __forceinline__ int opaque_tid(int wv) { int t; asm volatile("v_mbcnt_lo_u32_b32 %0, -1, 0\n\tv_mbcnt_hi_u32_b32 %0, -1, %0\n\tv_lshl_add_u32 %0, %1, 6, %0" : "=&v"(t) : "s"(wv)); return t; }
namespace pg8 {
#define PG8_LAS __attribute__((address_space(3)))
typedef unsigned short bf16_t;
typedef short bf16x8 __attribute__((ext_vector_type(8)));
typedef float f32x4 __attribute__((ext_vector_type(4)));
typedef unsigned u32x4 __attribute__((ext_vector_type(4)));
typedef unsigned u32x2 __attribute__((ext_vector_type(2)));
constexpr int BM = 256, BK = 64, HALF = 128, HTB = HALF * BK * 2, STAGE_BYTES = 8 * HTB, NXCD = 8, WGM = 8;

__host__ __device__ __forceinline__ int lds_byte(int r, int c) { const int st = (r >> 4) * 2 + (c >> 5), rr = r & 15, cc = c & 31, ob = rr * 64 + cc * 2; return st * 1024 + (ob ^ (((ob >> 9) & 1) << 5)); }
__host__ __device__ __forceinline__ void stage_rc(int b, int& R, int& C) { const int st = b / 1024, sb = b % 1024, swz = sb ^ (((sb >> 9) & 1) << 5); R = (st >> 1) * 16 + swz / 64; C = (st & 1) * 32 + (swz % 64) / 2; }

struct Unit { int pm, pn; };
struct Gemm { const bf16_t* A; const bf16_t* Bt; int M, N, K; };

struct StaticOrder {
    int nM, nN, nwg, G, c;
    __host__ __device__ void init(int M, int N, int G_, int c_) { nM = M / BM; nN = N / BM; nwg = nM * nN; G = G_; c = c_; }
    __host__ __device__ bool next(int i, Unit& u) const {
        const long L = (long)i * G + c; if (L >= nwg) return false;
        int wgid = (int)L; { const int q = nwg / NXCD, r = nwg % NXCD, xcd = wgid % NXCD, off = wgid / NXCD; wgid = (xcd < r ? xcd * (q + 1) : r * (q + 1) + (xcd - r) * q) + off; }
        const int nig = WGM * nN, gid = wgid / nig, fm = gid * WGM, gsz = (nM - fm) < WGM ? (nM - fm) : WGM;
        u.pm = fm + ((wgid % nig) % gsz); u.pn = (wgid % nig) / gsz; return true;
    }
};

template <class Epi, class Sched>
__device__ __forceinline__ void gemm_phase(int wv, PG8_LAS unsigned char* lds, const Gemm g, const Sched& S, const Epi& E) {
    const int tid = opaque_tid(wv), wid = __builtin_amdgcn_readfirstlane(tid >> 6), lane = tid & 63, wr = wid >> 2, wc = wid & 3, fr = lane & 15, fq = lane >> 4;
    const int K = g.K, nt = K / BK;
    unsigned voffA[2], voffB[2];
#pragma unroll
    for (int i = 0; i < 2; ++i) { int R, C; stage_rc(tid * 16 + i * 8192, R, C); voffA[i] = (unsigned)(R * K + C) * 2u; voffB[i] = (unsigned)(R * K + C) * 2u; }
    const size_t kstep = (size_t)(BK * 2);
    const size_t hstep = (size_t)HALF * K * 2;
    const size_t tstep = 2 * hstep;
    const unsigned ldsw = (unsigned)wid * 1024u;
    const int aoff = lds_byte(wr * 64 + fr, fq * 8), boff = lds_byte(wc * 32 + fr, fq * 8);
#define PG8_SA(b, h) (((b) * 2 + (h)) * HTB)
#define PG8_SB(b, h) ((4 + (b) * 2 + (h)) * HTB)
#define PG8_STAGE(bufoff, gbase, voff) do { _Pragma("unroll") for (int _i = 0; _i < 2; ++_i) \
        __builtin_amdgcn_global_load_lds((const unsigned*)((const char*)(gbase) + (voff)[_i]), (PG8_LAS unsigned*)(lds + (bufoff) + ldsw + _i * 8192), 16, 0, 0); } while (0)
#define PG8_LDA(dst, b, h) do { _Pragma("unroll") for (int m = 0; m < 4; ++m) _Pragma("unroll") for (int k = 0; k < 2; ++k) dst[m][k] = *(const PG8_LAS bf16x8*)(lds + PG8_SA(b, h) + aoff + m * 2048 + k * 1024); } while (0)
#define PG8_LDB(dst, b, h) do { _Pragma("unroll") for (int n = 0; n < 2; ++n) _Pragma("unroll") for (int k = 0; k < 2; ++k) dst[n][k] = *(const PG8_LAS bf16x8*)(lds + PG8_SB(b, h) + boff + n * 2048 + k * 1024); } while (0)
#define PG8_MMA(ai, bj, At, Bt) do { __builtin_amdgcn_s_setprio(1); _Pragma("unroll") for (int m = 0; m < 4; ++m) _Pragma("unroll") for (int n = 0; n < 2; ++n) _Pragma("unroll") for (int k = 0; k < 2; ++k) \
        acc[ai][bj][m][n] = __builtin_amdgcn_mfma_f32_16x16x32_bf16(Bt[n][k], At[m][k], acc[ai][bj][m][n], 0, 0, 0); __builtin_amdgcn_s_setprio(0); } while (0)
#define PG8_WAIT_V(n) asm volatile("s_waitcnt vmcnt(" #n ")" ::: "memory")
#define PG8_WAIT_L(n) asm volatile("s_waitcnt lgkmcnt(" #n ")" ::: "memory")
#define PG8_BAR __builtin_amdgcn_s_barrier()
#define PG8_SCHED __builtin_amdgcn_sched_barrier(0)
    Unit cur, nxt; int ui = 0;
    if (!S.next(0, cur)) return;
    f32x4 acc[2][2][4][2];
#pragma unroll
    for (int a = 0; a < 2; ++a)
#pragma unroll
        for (int b = 0; b < 2; ++b)
#pragma unroll
            for (int m = 0; m < 4; ++m)
#pragma unroll
                for (int n = 0; n < 2; ++n) acc[a][b][m][n] = (f32x4){0.f, 0.f, 0.f, 0.f};
    bf16x8 At[4][2], B0[2][2], B1[2][2];
    const char* cA = (const char*)g.A + (size_t)cur.pm * tstep; const char* cB = (const char*)g.Bt + (size_t)cur.pn * tstep;
    PG8_STAGE(PG8_SB(0, 0), cB, voffB); PG8_STAGE(PG8_SA(0, 0), cA, voffA); PG8_STAGE(PG8_SB(0, 1), cB + hstep, voffB); PG8_STAGE(PG8_SA(0, 1), cA + hstep, voffA);
    if (wr == 1) PG8_BAR;
    PG8_WAIT_V(4); PG8_BAR;
    PG8_STAGE(PG8_SB(1, 0), cB + kstep, voffB); PG8_STAGE(PG8_SA(1, 0), cA + kstep, voffA); PG8_STAGE(PG8_SB(1, 1), cB + hstep + kstep, voffB);
    PG8_WAIT_V(6); PG8_BAR;
    for (;;) {
        const bool has_next = S.next(ui + 1, nxt);
        const char* nA = has_next ? (const char*)g.A + (size_t)nxt.pm * tstep : cA; const char* nB = has_next ? (const char*)g.Bt + (size_t)nxt.pn * tstep : cB;
        for (int t = 0; t < nt; t += 2) {
            const bool last = (t == nt - 2);
            const char* a1 = cA + (size_t)(t + 1) * kstep;
            const char* a2 = last ? nA : cA + (size_t)(t + 2) * kstep; const char* b2 = last ? nB : cB + (size_t)(t + 2) * kstep;
            const char* a3 = a2 + kstep; const char* b3 = b2 + kstep;
            PG8_LDB(B0, 0, 0); PG8_SCHED; PG8_LDA(At, 0, 0); PG8_STAGE(PG8_SA(1, 1), a1 + hstep, voffA);
            PG8_WAIT_L(8); PG8_BAR; PG8_WAIT_L(0); PG8_MMA(0, 0, At, B0); PG8_BAR; PG8_SCHED;
            PG8_LDB(B1, 0, 1); PG8_STAGE(PG8_SB(0, 0), b2, voffB);
            PG8_BAR; PG8_WAIT_L(0); PG8_MMA(0, 1, At, B1); PG8_BAR;
            PG8_LDA(At, 0, 1); PG8_STAGE(PG8_SA(0, 0), a2, voffA);
            PG8_BAR; PG8_WAIT_L(0); PG8_MMA(1, 0, At, B0); PG8_BAR; PG8_SCHED;
            PG8_STAGE(PG8_SB(0, 1), b2 + hstep, voffB);
            PG8_WAIT_V(6); PG8_BAR; PG8_MMA(1, 1, At, B1); PG8_BAR;
            PG8_LDB(B0, 1, 0); PG8_SCHED; PG8_LDA(At, 1, 0); PG8_STAGE(PG8_SA(0, 1), a2 + hstep, voffA);
            PG8_WAIT_L(8); PG8_BAR; PG8_WAIT_L(0); PG8_MMA(0, 0, At, B0); PG8_BAR; PG8_SCHED;
            PG8_LDB(B1, 1, 1); PG8_STAGE(PG8_SB(1, 0), b3, voffB);
            PG8_BAR; PG8_WAIT_L(0); PG8_MMA(0, 1, At, B1); PG8_BAR;
            PG8_LDA(At, 1, 1); PG8_STAGE(PG8_SA(1, 0), a3, voffA);
            PG8_BAR; PG8_WAIT_L(0); PG8_MMA(1, 0, At, B0); PG8_BAR; PG8_SCHED;
            PG8_STAGE(PG8_SB(1, 1), b3 + hstep, voffB);
            PG8_WAIT_V(6); PG8_BAR; PG8_MMA(1, 1, At, B1); PG8_BAR;
        }
        E(acc, cur, wr, wc, fr, fq);
        if (!has_next) break;
#pragma unroll
        for (int a = 0; a < 2; ++a)
#pragma unroll
            for (int b = 0; b < 2; ++b)
#pragma unroll
                for (int m = 0; m < 4; ++m)
#pragma unroll
                    for (int n = 0; n < 2; ++n) acc[a][b][m][n] = (f32x4){0.f, 0.f, 0.f, 0.f};
        cur = nxt; cA = nA; cB = nB; ++ui;
    }
    PG8_WAIT_V(0);
    if (wr == 0) PG8_BAR;
    PG8_BAR;
#undef PG8_SA
#undef PG8_SB
#undef PG8_STAGE
#undef PG8_LDA
#undef PG8_LDB
#undef PG8_MMA
#undef PG8_WAIT_V
#undef PG8_WAIT_L
#undef PG8_BAR
#undef PG8_SCHED
}
}

using pg8::bf16_t; using pg8::bf16x8; using pg8::f32x4; using pg8::u32x2; using pg8::u32x4; using pg8::Unit;

constexpr int MROWS = 17408, MP = 16384, DM = 1024, LDZ = 3328, DFF = 4096, NIN = 41;
constexpr float EPSF = 1e-6f;
constexpr int LDS_BYTES = 139264 + 256;
constexpr int LDS_XB = 139264;

constexpr size_t WS_BIG = 0;
constexpr size_t BIG_BYTES = (size_t)MROWS * DFF * 2;
constexpr size_t WS_WB = WS_BIG + BIG_BYTES;
constexpr size_t WO_IN_AB = 0;
constexpr size_t WO_OUT_AB = WO_IN_AB + (size_t)LDZ * 1024;
constexpr size_t WO_UP0 = WO_OUT_AB + (size_t)1024 * 1024;
constexpr size_t WO_DOWN0 = WO_UP0 + (size_t)4096 * 1024;
constexpr size_t WO_GATE0 = WO_DOWN0 + (size_t)4096 * 1024;
constexpr size_t WO_PROJ0 = WO_GATE0 + (size_t)1024 * 1024;
constexpr size_t WO_IN_CD = WO_PROJ0 + (size_t)1024 * 256;
constexpr size_t WO_GLU = WO_IN_CD + (size_t)1024 * 1024;
constexpr size_t WO_OUT_CD = WO_GLU + (size_t)512 * 512;
constexpr size_t WO_UP1 = WO_OUT_CD + (size_t)1024 * 1024;
constexpr size_t WO_DOWN1 = WO_UP1 + (size_t)4096 * 1024;
constexpr size_t WO_GATE1 = WO_DOWN1 + (size_t)4096 * 1024;
constexpr size_t WO_PROJ1 = WO_GATE1 + (size_t)1024 * 1024;
constexpr size_t WB_ELEMS = WO_PROJ1 + (size_t)1024 * 256;
constexpr size_t WS_X = WS_WB + WB_ELEMS * 2;
constexpr size_t ABUF_BYTES = (size_t)MROWS * DM * 2;
constexpr size_t WS_Y = WS_X + ABUF_BYTES;
constexpr size_t WS_SS = WS_Y + ABUF_BYTES;
constexpr size_t WS_BAR = WS_SS + (size_t)7 * MROWS * 4;
constexpr size_t WS_END = WS_BAR + 16384;
static_assert(WS_END <= (size_t)268435456, "workspace over 256 MiB");
constexpr size_t BIG_Z1 = 0;
constexpr size_t BIG_YG = (size_t)MROWS * DM * 4;
constexpr size_t BIG_META = (size_t)MROWS * LDZ * 2;

constexpr size_t O_Y = 0;
constexpr size_t O_CONV_P = (size_t)MROWS * DM;
constexpr size_t O_DELTA_P = O_CONV_P + 8 * 3 * 1536;
constexpr size_t O_SGUV_P = O_DELTA_P + (size_t)8 * 4 * 128 * 128;
constexpr size_t O_POOL_P = O_SGUV_P + (size_t)8 * 128 * 512;
constexpr size_t O_S5RE_P = O_POOL_P + (size_t)8 * 15 * 512;
constexpr size_t O_S5IM_P = O_S5RE_P + (size_t)8 * 32 * 64;
constexpr size_t O_CONV_S = O_S5IM_P + (size_t)8 * 32 * 64;
constexpr size_t O_DELTA_S = O_CONV_S + (size_t)128 * 3 * 1536;
constexpr size_t O_SGUV_S = O_DELTA_S + (size_t)128 * 4 * 128 * 128;
constexpr size_t O_POOL_S = O_SGUV_S + (size_t)128 * 8 * 512;
constexpr size_t O_S5RE_S = O_POOL_S + (size_t)128 * 15 * 512;
constexpr size_t O_S5IM_S = O_S5RE_S + (size_t)128 * 32 * 64;
constexpr size_t O_END = O_S5IM_S + (size_t)128 * 32 * 64;

enum { I_XP = 0, I_XS, I_SCONV, I_SDELTA, I_SPOOL, I_S5RE, I_S5IM, I_PP, I_PS, I_NMIX, I_NFFN, I_NPE, I_NFINAL, I_WINAB, I_CONVW, I_ALOG, I_DTB, I_NORMO, I_LNG, I_LNB,
       I_WSP, I_BSP, I_WOUTAB, I_WINCD, I_WPOOL, I_PSCALE, I_LAMRE, I_LAMIM, I_LOGDT, I_BRE, I_BIM, I_CRE, I_CIM, I_DSKIP, I_WGLU, I_BGLU, I_WOUTCD, I_WUP, I_WDOWN, I_WPROJ, I_WGATE };

struct Params { const float* in[NIN]; float* out; unsigned char* ws; };

__device__ __forceinline__ float bf2f(bf16_t v) { return __uint_as_float(((unsigned)v) << 16); }
__device__ __forceinline__ unsigned pk2(float lo, float hi) { unsigned r; asm volatile("v_cvt_pk_bf16_f32 %0, %1, %2" : "=v"(r) : "v"(lo), "v"(hi)); return r; }
__device__ __forceinline__ bf16_t f2bf(float f) { return (bf16_t)(pk2(f, 0.f) & 0xffffu); }
__device__ __forceinline__ float sigmoidf_(float x) { return 1.0f / (1.0f + __expf(-x)); }
__device__ __forceinline__ float siluf_(float x) { return x / (1.0f + __expf(-x)); }
__device__ __forceinline__ float geluf_(float x) { const float y = 1.5957691216f * (x + 0.044715f * x * x * x); return x / (1.0f + __expf(-y)); }
template <int CTRL> __device__ __forceinline__ float dpp_f(float x) { return __builtin_bit_cast(float, __builtin_amdgcn_mov_dpp(__builtin_bit_cast(int, x), CTRL, 0xf, 0xf, true)); }
__device__ __forceinline__ float row16_sum(float v) { v += dpp_f<0xB1>(v); v += dpp_f<0x4E>(v); v += dpp_f<0x141>(v); v += dpp_f<0x140>(v); return v; }
__device__ __forceinline__ float rdlane(float v, int l) { return __builtin_bit_cast(float, __builtin_amdgcn_readlane(__builtin_bit_cast(int, v), l)); }
__device__ __forceinline__ float wave_sum(float v) { v = row16_sum(v); return (rdlane(v, 0) + rdlane(v, 16)) + (rdlane(v, 32) + rdlane(v, 48)); }
__device__ __forceinline__ float shfl_xor_l(float v, int lane, int m) { return __builtin_bit_cast(float, __builtin_amdgcn_ds_bpermute((lane ^ m) << 2, __builtin_bit_cast(int, v))); }
__device__ __forceinline__ float rstd_of(const float* ss, int row) { return rsqrtf(ss[row] * (1.0f / 1024.0f) + EPSF); }

#define EPI_LOOP_ROWS for (int ai = 0; ai < 2; ++ai) for (int m = 0; m < 4; ++m)
#define EPI_LOOP_COLS for (int bj = 0; bj < 2; ++bj) for (int n = 0; n < 2; ++n)

struct EpiZ {
    bf16_t* Z; int ldz; const float* ss;
    __device__ __forceinline__ void operator()(const f32x4 (&acc)[2][2][4][2], const Unit& u, int wr, int wc, int fr, int fq) const {
        const int row0 = u.pm * 256 + wr * 64 + fr, col0 = u.pn * 256 + wc * 32 + 4 * fq;
#pragma unroll
        EPI_LOOP_ROWS { const int row = row0 + ai * 128 + m * 16; const float rs = rstd_of(ss, row); bf16_t* rp = Z + (size_t)row * ldz + col0;
#pragma unroll
            EPI_LOOP_COLS { const f32x4 v = acc[ai][bj][m][n] * rs; u32x2 w; w.x = pk2(v[0], v[1]); w.y = pk2(v[2], v[3]); *(u32x2*)(rp + bj * 128 + n * 16) = w; } }
    }
};
struct QZ1 {
    float* Z; const float* ss;
    __device__ __forceinline__ float operator()(int row, int col, const f32x4 a) const { *(f32x4*)(Z + (size_t)row * 1024 + col) = a * rstd_of(ss, row); return 0.f; }
};
struct QUp {
    bf16_t* Hd; const float* ss;
    __device__ __forceinline__ float operator()(int row, int col, const f32x4 a) const { f32x4 v = a * rstd_of(ss, row);
#pragma unroll
        for (int j = 0; j < 4; ++j) { const float r = fmaxf(v[j], 0.f); v[j] = r * r; }
        u32x2 w; w.x = pk2(v[0], v[1]); w.y = pk2(v[2], v[3]); *(u32x2*)(Hd + (size_t)row * DFF + col) = w; return 0.f; }
};
__device__ __forceinline__ f32x4 bf4_to_f(const u32x2 r) { f32x4 y; y[0] = __uint_as_float(r.x << 16); y[1] = __uint_as_float(r.x & 0xffff0000u); y[2] = __uint_as_float(r.y << 16); y[3] = __uint_as_float(r.y & 0xffff0000u); return y; }
struct QResF {
    const float* resP; const float* resS; bf16_t* HB;
    __device__ __forceinline__ float operator()(int row, int col, const f32x4 a) const {
        const float* rr = (row < MP ? resP + (size_t)row * 1024 : resS + (size_t)(row - MP) * 1024) + col; const f32x4 v = *(const f32x4*)rr + a;
        u32x2 w; w.x = pk2(v[0], v[1]); w.y = pk2(v[2], v[3]); *(u32x2*)(HB + (size_t)row * 1024 + col) = w;
        return (v[0] * v[0] + v[1] * v[1]) + (v[2] * v[2] + v[3] * v[3]); }
};
struct QResB {
    const bf16_t* R; bf16_t* HB;
    __device__ __forceinline__ float operator()(int row, int col, const f32x4 a) const {
        const f32x4 v = bf4_to_f(*(const u32x2*)(R + (size_t)row * 1024 + col)) + a;
        u32x2 w; w.x = pk2(v[0], v[1]); w.y = pk2(v[2], v[3]); *(u32x2*)(HB + (size_t)row * 1024 + col) = w;
        return (v[0] * v[0] + v[1] * v[1]) + (v[2] * v[2] + v[3] * v[3]); }
};
struct QGate {
    bf16_t* G; const float* ss;
    __device__ __forceinline__ float operator()(int row, int col, const f32x4 a) const { f32x4 v = a * rstd_of(ss, row);
#pragma unroll
        for (int j = 0; j < 4; ++j) v[j] = sigmoidf_(v[j]);
        u32x2 w; w.x = pk2(v[0], v[1]); w.y = pk2(v[2], v[3]); *(u32x2*)(G + (size_t)row * 1024 + col) = w; return 0.f; }
};
struct QProj {
    const bf16_t* G; const bf16_t* R; bf16_t* HB;
    __device__ __forceinline__ float operator()(int row, int col, const f32x4 a) const {
        const f32x4 v = bf4_to_f(*(const u32x2*)(R + (size_t)row * 1024 + col)) + a * bf4_to_f(*(const u32x2*)(G + (size_t)row * 1024 + col));
        u32x2 w; w.x = pk2(v[0], v[1]); w.y = pk2(v[2], v[3]); *(u32x2*)(HB + (size_t)row * 1024 + col) = w;
        return (v[0] * v[0] + v[1] * v[1]) + (v[2] * v[2] + v[3] * v[3]); }
};
template <class Q, bool HAS_SS> struct EpiQ {
    Q q; float* ssout;
    __device__ __forceinline__ void operator()(const f32x4 (&acc)[2][2][4][2], const Unit& u, int wr, int wc, int fr, int fq) const {
        const int row0 = u.pm * 256 + wr * 64 + fr, col0 = u.pn * 256 + wc * 32 + 4 * fq;
#pragma unroll
        EPI_LOOP_ROWS { const int row = row0 + ai * 128 + m * 16; float s = 0.f;
#pragma unroll
            EPI_LOOP_COLS { s += q(row, col0 + bj * 128 + n * 16, acc[ai][bj][m][n]); }
            if (HAS_SS) { s += shfl_xor_l(s, fq * 16 + fr, 16); s += shfl_xor_l(s, fq * 16 + fr, 32); if (fq == 0) atomicAdd(ssout + row, s); } }
    }
};
template <class Q, bool HAS_SS, int KSPLIT = 8>
__device__ __forceinline__ void tail_gemm(int wv, unsigned char* smem_b, const bf16_t* A  , int lda, const bf16_t* Bt, int N, int K, const Q& q, float* ssout) {
    constexpr int TP = 8 / KSPLIT;
    const int tid = opaque_tid(wv), lane = tid & 63, wid = __builtin_amdgcn_readfirstlane(tid >> 6), fr = lane & 15, fq = lane >> 4;
    const int ntn = N >> 6, ngroups = (16 * ntn) / TP, kw = K / KSPLIT, ts = wid / KSPLIT, k_lo = (wid % KSPLIT) * kw;
    f32x4* red = (f32x4*)smem_b;
    for (int g = blockIdx.x; g < ngroups; g += gridDim.x) {
        const int t = g * TP + ts, r0 = (t / ntn) * 64, c0 = (t % ntn) * 64;
        const bf16_t* ap = A + (size_t)(r0 + fr) * lda + k_lo + fq * 8; const bf16_t* bp = Bt + (size_t)(c0 + fr) * K + k_lo + fq * 8;
        f32x4 acc[4][4];
#pragma unroll
        for (int i = 0; i < 4; ++i)
#pragma unroll
            for (int j = 0; j < 4; ++j) acc[i][j] = (f32x4){0.f, 0.f, 0.f, 0.f};
#pragma unroll 2
        for (int k0 = 0; k0 < kw; k0 += 32) {
            bf16x8 af[4], bf[4];
#pragma unroll
            for (int i = 0; i < 4; ++i) { af[i] = *(const bf16x8*)(ap + (size_t)(i * 16) * lda + k0); bf[i] = *(const bf16x8*)(bp + (size_t)(i * 16) * K + k0); }
#pragma unroll
            for (int i = 0; i < 4; ++i)
#pragma unroll
                for (int j = 0; j < 4; ++j) acc[i][j] = __builtin_amdgcn_mfma_f32_16x16x32_bf16(bf[j], af[i], acc[i][j], 0, 0, 0);
        }
        __syncthreads();
#pragma unroll
        for (int i = 0; i < 4; ++i)
#pragma unroll
            for (int j = 0; j < 4; ++j) red[(wid * 16 + i * 4 + j) * 64 + lane] = acc[i][j];
        __syncthreads();
#pragma unroll
        for (int hq = 0; hq < 2 * TP; ++hq) {
            const int qd = tid + hq * 512, tsq = qd >> 10, ij = (qd >> 6) & 15, ln = qd & 63; f32x4 v = red[((tsq * KSPLIT) * 16 + ij) * 64 + ln];
#pragma unroll
            for (int w = 1; w < KSPLIT; ++w) v += red[((tsq * KSPLIT + w) * 16 + ij) * 64 + ln];
            const int tq = g * TP + tsq, r0q = (tq / ntn) * 64, c0q = (tq % ntn) * 64;
            const int row = MP + r0q + (ij >> 2) * 16 + (ln & 15), col = c0q + (ij & 3) * 16 + (ln >> 4) * 4;
            float sq = q(row, col, v);
            if (HAS_SS) { sq += shfl_xor_l(sq, lane, 16); sq += shfl_xor_l(sq, lane, 32); if (fq == 0) atomicAdd(ssout + row, sq); }
        }
    }
}
struct EpiGlu {
    const bf16_t* YG; const float* bg; bf16_t* Mix;
    __device__ __forceinline__ void operator()(const f32x4 (&acc)[2][2][4][2], const Unit& u, int wr, int wc, int fr, int fq) const {
        const int row0 = u.pm * 256 + wr * 64 + fr, col0 = u.pn * 256 + wc * 32 + 4 * fq;
#pragma unroll
        EPI_LOOP_ROWS { const int row = row0 + ai * 128 + m * 16;
#pragma unroll
            EPI_LOOP_COLS { const int col = col0 + bj * 128 + n * 16; const u32x2 yv = *(const u32x2*)(YG + (size_t)row * 512 + col); const f32x4 b = *(const f32x4*)(bg + col);
                const f32x4 a = acc[ai][bj][m][n] + b; f32x4 y; y[0] = __uint_as_float(yv.x << 16); y[1] = __uint_as_float(yv.x & 0xffff0000u); y[2] = __uint_as_float(yv.y << 16); y[3] = __uint_as_float(yv.y & 0xffff0000u);
                f32x4 v;
#pragma unroll
                for (int j = 0; j < 4; ++j) v[j] = y[j] * sigmoidf_(a[j]);
                u32x2 w; w.x = pk2(v[0], v[1]); w.y = pk2(v[2], v[3]); *(u32x2*)(Mix + (size_t)row * 1024 + 512 + col) = w; } }
    }
};

template <class Epi>
__device__ __forceinline__ void run_gemm(int wv, PG8_LAS unsigned char* lds, const bf16_t* A, const bf16_t* Bt, int M, int N, int K, const Epi& E) {
    pg8::StaticOrder S; S.init(M, N, (int)gridDim.x, (int)blockIdx.x);
    pg8::Gemm g{A, Bt, M, N, K};
    pg8::gemm_phase<Epi, pg8::StaticOrder>(wv, lds, g, S, E);
}

__device__ __forceinline__ void conv_outcd_fold(int wv, float* smem, const float* W, const float* wp, const float* sc, bf16_t* dst, int& tcount, int bid, int nb) {
    const int tid = opaque_tid(wv);
    float* tile = smem; float* As = smem + 64 * 65; float* Bs = As + 64 * 129;
    for (int t = (bid - tcount % nb + nb) % nb; t < 8 * 16; t += nb) {
        const int k0 = (t & 7) * 64, n0 = (t >> 3) * 64, gi = k0 >> 7, i0 = k0 & 127;
        __syncthreads();
#pragma unroll
        for (int i = 0; i < 16; ++i) { const int e = tid + i * 512, ii = e >> 7, j = e & 127; As[ii * 129 + j] = wp[((size_t)gi * 128 + i0 + ii) * 128 + j] * sc[gi * 128 + j]; }
#pragma unroll
        for (int i = 0; i < 16; ++i) { const int e = tid + i * 512, j = e >> 6, jn = e & 63; Bs[j * 65 + jn] = W[(size_t)(gi * 128 + j) * 1024 + n0 + jn]; }
        __syncthreads();
        {
            const int jn = tid & 63, ikb = tid >> 6; float acc[8];
#pragma unroll
            for (int i = 0; i < 8; ++i) acc[i] = 0.f;
            for (int j = 0; j < 128; ++j) { const float bv = Bs[j * 65 + jn];
#pragma unroll
                for (int i = 0; i < 8; ++i) acc[i] += As[(ikb + i * 8) * 129 + j] * bv; }
#pragma unroll
            for (int i = 0; i < 8; ++i) tile[(ikb + i * 8) * 65 + jn] = acc[i];
        }
        __syncthreads();
#pragma unroll
        for (int i = 0; i < 4; ++i) { const int e = tid + i * 512, jn = e >> 5, ik = (e & 31) * 2;
            *(unsigned*)(dst + (size_t)(n0 + jn) * 1024 + k0 + ik) = pk2(tile[ik * 65 + jn], tile[(ik + 1) * 65 + jn]); }
    }
    tcount += 8 * 16;
}

__device__ __forceinline__ void conv_weight(int wv, float* tile, const float* W, const float* g, bf16_t* dst, int K, int N, int Npad, int& tcount, int bid, int nb, int ldd = 0, int koff = 0) {
    if (ldd == 0) ldd = K;
    const int nkt = K / 64, nnt = Npad / 256, tot = nkt * nnt, tid = opaque_tid(wv), lane = tid & 63, wid = tid >> 6;
    for (int t = (bid - tcount % nb + nb) % nb; t < tot; t += nb) {
        const int k0 = (t % nkt) * 64, n0 = (t / nkt) * 256, n = n0 + lane * 4;
        f32x4 v[8];
#pragma unroll
        for (int i = 0; i < 8; ++i) { const int k = k0 + wid * 8 + i;
            if (n + 3 < N) v[i] = *(const f32x4*)(W + (size_t)k * N + n);
            else { v[i] = (f32x4){0.f, 0.f, 0.f, 0.f};
#pragma unroll
                for (int e = 0; e < 4; ++e) if (n + e < N) v[i][e] = W[(size_t)k * N + n + e]; }
            if (g) v[i] *= g[k]; }
        __syncthreads();
#pragma unroll
        for (int i = 0; i < 8; ++i) {
#pragma unroll
            for (int e = 0; e < 4; ++e) tile[(wid * 8 + i) * 257 + lane * 4 + e] = v[i][e]; }
        __syncthreads();
#pragma unroll
        for (int i = 0; i < 16; ++i) { const int e = tid + i * 512, jn = e >> 5, ik = (e & 31) * 2;
            *(unsigned*)(dst + (size_t)(n0 + jn) * ldd + koff + k0 + ik) = pk2(tile[ik * 257 + jn], tile[(ik + 1) * 257 + jn]); }
    }
    tcount += tot;
}

__device__ __forceinline__ void convert_rest(int wv, const Params& p, float* smem, int vb, int nvb) {
    bf16_t* WB = (bf16_t*)(p.ws + WS_WB);
    int tc = 0;
    conv_weight(wv, smem, p.in[I_WOUTAB], nullptr, WB + WO_OUT_AB, 1024, 1024, 1024, tc, vb, nvb);
    conv_weight(wv, smem, p.in[I_WUP], p.in[I_NFFN], WB + WO_UP0, 1024, 4096, 4096, tc, vb, nvb);
    conv_weight(wv, smem, p.in[I_WDOWN], nullptr, WB + WO_DOWN0, 4096, 1024, 1024, tc, vb, nvb);
    conv_weight(wv, smem, p.in[I_WGATE], p.in[I_NPE], WB + WO_GATE0, 1024, 1024, 1024, tc, vb, nvb);
    conv_weight(wv, smem, p.in[I_WPROJ], nullptr, WB + WO_PROJ0, 256, 1024, 1024, tc, vb, nvb);
    conv_weight(wv, smem, p.in[I_WINCD], p.in[I_NMIX] + 1024, WB + WO_IN_CD, 1024, 1024, 1024, tc, vb, nvb);
    conv_weight(wv, smem, p.in[I_WGLU], nullptr, WB + WO_GLU, 512, 512, 512, tc, vb, nvb);
    conv_outcd_fold(wv, smem, p.in[I_WOUTCD], p.in[I_WPOOL], p.in[I_PSCALE], WB + WO_OUT_CD, tc, vb, nvb);
    conv_weight(wv, smem, p.in[I_WOUTCD] + (size_t)512 * 1024, nullptr, WB + WO_OUT_CD, 512, 1024, 1024, tc, vb, nvb, 1024, 512);
    conv_weight(wv, smem, p.in[I_WUP] + (size_t)1024 * 4096, p.in[I_NFFN] + 1024, WB + WO_UP1, 1024, 4096, 4096, tc, vb, nvb);
    conv_weight(wv, smem, p.in[I_WDOWN] + (size_t)4096 * 1024, nullptr, WB + WO_DOWN1, 4096, 1024, 1024, tc, vb, nvb);
    conv_weight(wv, smem, p.in[I_WGATE] + (size_t)1024 * 1024, p.in[I_NPE] + 1024, WB + WO_GATE1, 1024, 1024, 1024, tc, vb, nvb);
    conv_weight(wv, smem, p.in[I_WPROJ] + (size_t)256 * 1024, nullptr, WB + WO_PROJ1, 256, 1024, 1024, tc, vb, nvb);
}
__device__ __forceinline__ void phase0(int wv, const Params& p, float* smem) {
    bf16_t* WB = (bf16_t*)(p.ws + WS_WB);
    int tc = 0;
    conv_weight(wv, smem, p.in[I_WINAB], p.in[I_NMIX], WB + WO_IN_AB, 1024, 3080, LDZ, tc, (int)blockIdx.x, (int)gridDim.x);
    const int tid0 = opaque_tid(wv), lane = tid0 & 63, gw = blockIdx.x * 8 + (tid0 >> 6), nw = gridDim.x * 8;
    bf16_t* X = (bf16_t*)(p.ws + WS_X); float* ss = (float*)(p.ws + WS_SS);
    for (int rowa = gw; rowa < MROWS; rowa += 4 * nw) {
        f32x4 v[4][4];
#pragma unroll
        for (int k = 0; k < 4; ++k) { const int row = rowa + k * nw < MROWS ? rowa + k * nw : rowa;
            const float* xr = row < MP ? p.in[I_XP] + (size_t)row * 1024 : p.in[I_XS] + (size_t)(row - MP) * 1024;
#pragma unroll
            for (int i = 0; i < 4; ++i) v[k][i] = *(const f32x4*)(xr + (i * 64 + lane) * 4); }
#pragma unroll
        for (int k = 0; k < 4; ++k) { const int row = rowa + k * nw; float sq = 0.f;
            if (row < MROWS) {
#pragma unroll
                for (int i = 0; i < 4; ++i) { const f32x4 x = v[k][i]; sq += (x[0] * x[0] + x[1] * x[1]) + (x[2] * x[2] + x[3] * x[3]);
                    u32x2 w; w.x = pk2(x[0], x[1]); w.y = pk2(x[2], x[3]); *(u32x2*)(X + (size_t)row * 1024 + (i * 64 + lane) * 4) = w; }
                sq = wave_sum(sq);
                if (lane == 0) ss[row] = sq; } }
    }
    for (int i = blockIdx.x * 512 + tid0; i < 6 * MROWS; i += gridDim.x * 512) ss[MROWS + i] = 0.f;
}

struct DRaw { u32x4 qk[4]; u32x4 v[4]; f32x4 m; };
constexpr int DBUF_F = 32 * 128 * 2 + 32 * 16 + 32 * 4 + 32 * 16;
constexpr int DBUF_O = 32 * 128 * 2 + 32 * 16 + 32 * 4;
__device__ __forceinline__ void bf8_to_f(const u32x4 r, float (&x)[8]) {
#pragma unroll
    for (int i = 0; i < 4; ++i) { x[2 * i] = __uint_as_float(r[i] << 16); x[2 * i + 1] = __uint_as_float(r[i] & 0xffff0000u); } }

__device__ __forceinline__ void phase2p(int wv, const Params& p, float* smem) {
    const int tid = opaque_tid(wv), lane = tid & 63, wid = __builtin_amdgcn_readfirstlane(tid >> 6), nb = gridDim.x, bid = blockIdx.x;
    const bf16_t* Z = (const bf16_t*)(p.ws + WS_BIG); bf16_t* QK = (bf16_t*)(p.ws + WS_Y); f32x4* META = (f32x4*)(p.ws + WS_BIG + BIG_META);
    const float* cw = p.in[I_CONVW];
    const int half = wid >> 2, pw = wid & 3, pt = tid & 255, cv = pt & 31, tg = pt >> 5; const bool isq = cv < 16;
    float* lw = smem + wid * 2048;
    const int tok8 = lane >> 3, pr = lane & 7;
    u32x4 rawN[7]; bf16_t zbN = 0, zaN = 0;
    auto fetch = [&](int u) {
        const int h = u & 3, rowc = (u >> 2) * 32, t0 = rowc & 2047, zc0 = isq ? h * 128 + cv * 8 : 512 + h * 128 + (cv - 16) * 8;
#pragma unroll
        for (int r = 0; r < 7; ++r) { const int dt_ = tg * 4 - 3 + r; rawN[r] = (t0 + dt_) >= 0 ? *(const u32x4*)(Z + (size_t)(rowc + dt_) * LDZ + zc0) : (u32x4){0u, 0u, 0u, 0u}; }
        const size_t mr = (size_t)(rowc + pw * 8 + tok8); zbN = Z[mr * LDZ + 2048 + h]; zaN = Z[mr * LDZ + 2052 + h]; };
    if (bid * 2 + half < 2048) fetch(bid * 2 + half);
    for (int u = bid * 2 + half; u < 2048; u += nb * 2) {
        const int h = u & 3, rowc = (u >> 2) * 32;
        const int zc0 = isq ? h * 128 + cv * 8 : 512 + h * 128 + (cv - 16) * 8;
        u32x4 raw[7];
#pragma unroll
        for (int r = 0; r < 7; ++r) raw[r] = rawN[r];
        const size_t mrow = (size_t)(rowc + pw * 8 + tok8);
        const bf16_t zbv = zbN, zav = zaN;
        if (u + nb * 2 < 2048) fetch(u + nb * 2);
        float w[4][8];
#pragma unroll
        for (int i = 0; i < 4; ++i) { const f32x4 a0 = *(const f32x4*)(cw + i * 1536 + zc0), a1 = *(const f32x4*)(cw + i * 1536 + zc0 + 4);
#pragma unroll
            for (int e = 0; e < 4; ++e) { w[i][e] = a0[e]; w[i][4 + e] = a1[e]; } }
        float x[7][8];
#pragma unroll
        for (int r = 0; r < 7; ++r) bf8_to_f(raw[r], x[r]);
#pragma unroll
        for (int j = 0; j < 4; ++j) { float y[8]; float sq = 0.f;
#pragma unroll
            for (int e = 0; e < 8; ++e) { const float a = w[0][e] * x[j][e] + w[1][e] * x[j + 1][e] + w[2][e] * x[j + 2][e] + w[3][e] * x[j + 3][e]; y[e] = siluf_(a); sq += y[e] * y[e]; }
            sq = row16_sum(sq);
            const float sc = rsqrtf(sq + EPSF) * (isq ? 0.08838834764831845f : 1.0f);
            u32x4 o; o[0] = pk2(y[0] * sc, y[1] * sc); o[1] = pk2(y[2] * sc, y[3] * sc); o[2] = pk2(y[4] * sc, y[5] * sc); o[3] = pk2(y[6] * sc, y[7] * sc);
            *(u32x4*)(QK + (size_t)(rowc + tg * 4 + j) * 1024 + zc0) = o;
            float* d = lw + ((tg & 1) * 4 + j) * 256 + (isq ? 0 : 128) + (cv & 15) * 8;
            float yr[8]; bf8_to_f(o, yr);
            *(f32x4*)d = (f32x4){yr[0], yr[1], yr[2], yr[3]}; *(f32x4*)(d + 4) = (f32x4){yr[4], yr[5], yr[6], yr[7]}; }
        asm volatile("s_waitcnt lgkmcnt(0)" ::: "memory");
        {   const float* qp = lw + tok8 * 256 + pr * 16; const float* kp = qp + 128; float sdot = 0.f;
#pragma unroll
            for (int i = 0; i < 4; ++i) { const f32x4 a = *(const f32x4*)(qp + i * 4), c = *(const f32x4*)(kp + i * 4); sdot += (a[0] * c[0] + a[1] * c[1]) + (a[2] * c[2] + a[3] * c[3]); }
            sdot += dpp_f<0xB1>(sdot); sdot += dpp_f<0x4E>(sdot); sdot += dpp_f<0x141>(sdot);
            const float* ap2 = (tok8 & 1) ? (lw + (tok8 - 1) * 256 + 128 + pr * 16) : kp; const float* bp2 = (tok8 & 1) ? qp : (lw + (tok8 + 1) * 256 + 128 + pr * 16); float sd2 = 0.f;
#pragma unroll
            for (int i = 0; i < 4; ++i) { const f32x4 a = *(const f32x4*)(ap2 + i * 4), c = *(const f32x4*)(bp2 + i * 4); sd2 += (a[0] * c[0] + a[1] * c[1]) + (a[2] * c[2] + a[3] * c[3]); }
            sd2 += dpp_f<0xB1>(sd2); sd2 += dpp_f<0x4E>(sd2); sd2 += dpp_f<0x141>(sd2);
            if (pr == 0) { const float za = bf2f(zav) + p.in[I_DTB][h]; const float sp = za > 20.f ? za : log1pf(__expf(za));
                META[mrow * 4 + h] = (f32x4){__expf(-__expf(p.in[I_ALOG][h]) * sp), sigmoidf_(bf2f(zbv)), sdot, sd2}; } }
        asm volatile("s_waitcnt lgkmcnt(0)" ::: "memory");
    }
}

__device__ __forceinline__ void delta_prompt_item(int wv, const Params& p, float* smem, int b, int h, int col0) {
    const int tid = opaque_tid(wv), lane = tid & 63, wid = __builtin_amdgcn_readfirstlane(tid >> 6);
    const int row0 = b * 2048;
    const bf16_t* Z = (const bf16_t*)(p.ws + WS_BIG);
    float* ORAW = (float*)(p.ws + WS_X);
    const float* cw = p.in[I_CONVW];
    constexpr int NCH = 64;
    __syncthreads();
    if (wid >= 4) {
        const int pt = tid - 256, cv = pt & 31, tg = pt >> 5;
        const bool isq = cv < 16;
        const int zc0 = isq ? h * 128 + cv * 8 : 512 + h * 128 + (cv - 16) * 8;
        const int cvv = pt & 1, tokv = (pt >> 1) & 31, zcv = 1024 + h * 128 + col0 + cvv * 8;
        float wvv[4][8];
#pragma unroll
        for (int i = 0; i < 4; ++i) {
            const f32x4 b0 = *(const f32x4*)(cw + i * 1536 + zcv), b1 = *(const f32x4*)(cw + i * 1536 + zcv + 4);
#pragma unroll
            for (int e = 0; e < 4; ++e) { wvv[i][e] = b0[e]; wvv[i][4 + e] = b1[e]; }
        }
        const bf16_t* QK = (const bf16_t*)(p.ws + WS_Y); const f32x4* META = (const f32x4*)(p.ws + WS_BIG + BIG_META);
        auto issue = [&](int ch, DRaw& R) {
            const int t0 = ch * 32;
#pragma unroll
            for (int j = 0; j < 4; ++j) R.qk[j] = *(const u32x4*)(QK + (size_t)(row0 + t0 + tg * 4 + j) * 1024 + zc0);
            if (pt < 64) {
#pragma unroll
                for (int i = 0; i < 4; ++i) { const int tp = t0 + tokv - 3 + i; R.v[i] = tp >= 0 ? *(const u32x4*)(Z + (size_t)(row0 + tp) * LDZ + zcv) : (u32x4){0u, 0u, 0u, 0u}; }
            } else if (pt < 96) R.m = META[(size_t)(row0 + t0 + pt - 64) * 4 + h];
        };
        auto process = [&](const DRaw& R, float* buf) {
            float* qs = buf; float* ks = buf + 32 * 128; float* vs = buf + 2 * 32 * 128; float* meta = vs + 32 * 16;
            float* dst = (isq ? qs : ks) + (cv & 15) * 8;
#pragma unroll
            for (int j = 0; j < 4; ++j) { float y[8]; bf8_to_f(R.qk[j], y);
                *(f32x4*)(dst + (tg * 4 + j) * 128) = (f32x4){y[0], y[1], y[2], y[3]}; *(f32x4*)(dst + (tg * 4 + j) * 128 + 4) = (f32x4){y[4], y[5], y[6], y[7]}; }
            if (pt < 64) { float xv[4][8];
#pragma unroll
                for (int i = 0; i < 4; ++i) bf8_to_f(R.v[i], xv[i]);
                float y[8];
#pragma unroll
                for (int e = 0; e < 8; ++e) y[e] = siluf_(wvv[0][e] * xv[0][e] + wvv[1][e] * xv[1][e] + wvv[2][e] * xv[2][e] + wvv[3][e] * xv[3][e]);
                *(f32x4*)(vs + tokv * 16 + cvv * 8) = (f32x4){y[0], y[1], y[2], y[3]}; *(f32x4*)(vs + tokv * 16 + cvv * 8 + 4) = (f32x4){y[4], y[5], y[6], y[7]};
            } else if (pt < 96) *(f32x4*)(meta + (pt - 64) * 4) = R.m;
        };
        auto flush = [&](int ch) { const int tok = pt >> 3, c2 = (pt & 7) * 2; const float* ob = smem + (ch & 1) * DBUF_F + DBUF_O + tok * 16 + c2;
            typedef float f32x2_ __attribute__((ext_vector_type(2)));
            *(f32x2_*)(ORAW + (size_t)(row0 + ch * 32 + tok) * 512 + h * 128 + col0 + c2) = *(const f32x2_*)ob; };
        DRaw R0, R1, R2, R3;
        issue(0, R0); issue(1, R1); issue(2, R2); issue(3, R3);
        process(R0, smem); issue(4, R0);
        __syncthreads();
        for (int j = 0; j < NCH; j += 4) {
            if (j + 1 < NCH) process(R1, smem + DBUF_F);
            if (j + 5 < NCH) issue(j + 5, R1);
            if (j > 0) flush(j - 1);
            __syncthreads();
            if (j + 2 < NCH) process(R2, smem);
            if (j + 6 < NCH) issue(j + 6, R2);
            flush(j);
            __syncthreads();
            if (j + 3 < NCH) process(R3, smem + DBUF_F);
            if (j + 7 < NCH) issue(j + 7, R3);
            flush(j + 1);
            __syncthreads();
            if (j + 4 < NCH) process(R0, smem);
            if (j + 8 < NCH) issue(j + 8, R0);
            flush(j + 2);
            __syncthreads();
        }
        flush(NCH - 1);
    } else {
        const int part = lane & 15, cl = lane >> 4, col = col0 + wid * 4 + cl;
        typedef float f32x2 __attribute__((ext_vector_type(2)));
        f32x2 S2[4];
#pragma unroll
        for (int i = 0; i < 4; ++i) S2[i] = (f32x2){0.f, 0.f};
        __syncthreads();
        for (int i = 0; i < NCH; ++i) {
            float* ob = smem + (i & 1) * DBUF_F + DBUF_O + wid * 4 + cl;
            const float* buf = smem + (i & 1) * DBUF_F; const float* qs = buf; const float* ks = buf + 32 * 128; const float* vs = buf + 2 * 32 * 128; const float* meta = vs + 32 * 16;
            struct Tok { f32x4 ka, kb, qa, qb, mt; float v; };
            auto ldtok = [&](int tt) { Tok T; T.ka = *(const f32x4*)(ks + tt * 128 + part * 4); T.kb = *(const f32x4*)(ks + tt * 128 + 64 + part * 4);
                T.qa = *(const f32x4*)(qs + tt * 128 + part * 4); T.qb = *(const f32x4*)(qs + tt * 128 + 64 + part * 4); T.mt = *(const f32x4*)(meta + tt * 4); T.v = vs[tt * 16 + wid * 4 + cl]; return T; };
            Tok t1 = ldtok(0), t2 = ldtok(1);
#pragma unroll 2
            for (int tt = 0; tt < 32; tt += 2) {
                const int tn = tt < 30 ? tt + 2 : 30;
                const Tok n1 = ldtok(tn), n2 = ldtok(tn + 1);
#define SPLIT4(v4, lo, hi) const f32x2 lo = __builtin_shufflevector(v4, v4, 0, 1), hi = __builtin_shufflevector(v4, v4, 2, 3)
                SPLIT4(t1.ka, k10, k11); SPLIT4(t1.kb, k12, k13); SPLIT4(t1.qa, q10, q11); SPLIT4(t1.qb, q12, q13);
                SPLIT4(t2.ka, k20, k21); SPLIT4(t2.kb, k22, k23); SPLIT4(t2.qa, q20, q21); SPLIT4(t2.qb, q22, q23);
#undef SPLIT4
                f32x2 p1 = S2[0] * k10; p1 = S2[1] * k11 + p1; p1 = S2[2] * k12 + p1; p1 = S2[3] * k13 + p1;
                f32x2 p2 = S2[0] * k20; p2 = S2[1] * k21 + p2; p2 = S2[2] * k22 + p2; p2 = S2[3] * k23 + p2;
                f32x2 p3 = S2[0] * q10; p3 = S2[1] * q11 + p3; p3 = S2[2] * q12 + p3; p3 = S2[3] * q13 + p3;
                f32x2 p4 = S2[0] * q20; p4 = S2[1] * q21 + p4; p4 = S2[2] * q22 + p4; p4 = S2[3] * q23 + p4;
                float dk1 = p1.x + p1.y, dk2 = p2.x + p2.y, dq1 = p3.x + p3.y, dq2 = p4.x + p4.y;
                dk1 += dpp_f<0xB1>(dk1); dk2 += dpp_f<0xB1>(dk2); dq1 += dpp_f<0xB1>(dq1); dq2 += dpp_f<0xB1>(dq2);
                dk1 += dpp_f<0x4E>(dk1); dk2 += dpp_f<0x4E>(dk2); dq1 += dpp_f<0x4E>(dq1); dq2 += dpp_f<0x4E>(dq2);
                dk1 += dpp_f<0x141>(dk1); dk2 += dpp_f<0x141>(dk2); dq1 += dpp_f<0x141>(dq1); dq2 += dpp_f<0x141>(dq2);
                dk1 += dpp_f<0x140>(dk1); dk2 += dpp_f<0x140>(dk2); dq1 += dpp_f<0x140>(dq1); dq2 += dpp_f<0x140>(dq2);
                const float a1 = t1.mt[0], a2 = t2.mt[0];
                const float u1 = t1.mt[1] * (t1.v - a1 * dk1);
                const float s1k2 = a1 * dk2 + t1.mt[3] * u1;
                const float u2 = t2.mt[1] * (t2.v - a2 * s1k2);
                const float o1 = a1 * dq1 + t1.mt[2] * u1;
                const float o2 = a2 * (a1 * dq2 + t2.mt[3] * u1) + t2.mt[2] * u2;
                const float a12 = a1 * a2, c1 = a2 * u1;
                const f32x2 A2 = (f32x2){a12, a12}, C1 = (f32x2){c1, c1}, U2 = (f32x2){u2, u2};
                S2[0] = S2[0] * A2 + k10 * C1 + k20 * U2; S2[1] = S2[1] * A2 + k11 * C1 + k21 * U2; S2[2] = S2[2] * A2 + k12 * C1 + k22 * U2; S2[3] = S2[3] * A2 + k13 * C1 + k23 * U2;
                ob[tt * 16] = o1; ob[(tt + 1) * 16] = o2;
                t1 = n1; t2 = n2;
            }
            __syncthreads();
        }
        float* sp = p.out + O_DELTA_P + ((size_t)(b * 4 + h) * 128) * 128 + col;
#pragma unroll
        for (int i = 0; i < 4; ++i) { const int d = (i >> 1) * 64 + part * 4 + (i & 1) * 2; sp[(size_t)d * 128] = S2[i].x; sp[(size_t)(d + 1) * 128] = S2[i].y; }
    }
}

__device__ __forceinline__ void delta_sample_item(int wv, const Params& p, float* smem, int b, int h) {
    const int tid = opaque_tid(wv), lane = tid & 63, wid = __builtin_amdgcn_readfirstlane(tid >> 6);
    const int row0 = MP + b * 8;
    const bf16_t* Z = (const bf16_t*)(p.ws + WS_BIG);
    float* ORAW = (float*)(p.ws + WS_X);
    const float* cw = p.in[I_CONVW]; const float* sconv = p.in[I_SCONV] + (size_t)b * 3 * 1536;
    float* Ssh = smem; float* qs = smem + 128 * 128; float* ks = qs + 8 * 128; float* vs = ks + 8 * 128; float* meta = vs + 8 * 128;
    const float* sin_ = p.in[I_SDELTA] + (size_t)(b * 4 + h) * 128 * 128;
    __syncthreads();
    f32x4 st[8];
#pragma unroll
    for (int i = 0; i < 8; ++i) st[i] = *(const f32x4*)(sin_ + (size_t)(i * 512 + tid) * 4);
    if (tid < 384) {
        const int tt = tid / 48, cvx = tid - tt * 48; int zc; float* dst;
        if (cvx < 16) { zc = h * 128 + cvx * 8; dst = qs + tt * 128 + cvx * 8; } else if (cvx < 32) { zc = 512 + h * 128 + (cvx - 16) * 8; dst = ks + tt * 128 + (cvx - 16) * 8; } else { zc = 1024 + h * 128 + (cvx - 32) * 8; dst = vs + tt * 128 + (cvx - 32) * 8; }
        float acc[8];
#pragma unroll
        for (int e = 0; e < 8; ++e) acc[e] = 0.f;
#pragma unroll
        for (int i = 0; i < 4; ++i) { const int tp = tt - 3 + i; float x[8];
            if (tp >= 0) { const u32x4 r = *(const u32x4*)(Z + (size_t)(row0 + tp) * LDZ + zc); bf8_to_f(r, x); }
            else { const f32x4 a = *(const f32x4*)(sconv + (tp + 3) * 1536 + zc), c = *(const f32x4*)(sconv + (tp + 3) * 1536 + zc + 4);
#pragma unroll
                for (int e = 0; e < 4; ++e) { x[e] = a[e]; x[4 + e] = c[e]; } }
            const f32x4 w0 = *(const f32x4*)(cw + i * 1536 + zc), w1 = *(const f32x4*)(cw + i * 1536 + zc + 4);
#pragma unroll
            for (int e = 0; e < 4; ++e) { acc[e] += w0[e] * x[e]; acc[4 + e] += w1[e] * x[4 + e]; } }
        *(f32x4*)dst = (f32x4){siluf_(acc[0]), siluf_(acc[1]), siluf_(acc[2]), siluf_(acc[3])}; *(f32x4*)(dst + 4) = (f32x4){siluf_(acc[4]), siluf_(acc[5]), siluf_(acc[6]), siluf_(acc[7])};
    } else if (tid < 392) { const int tt = tid - 384; const size_t r = (size_t)(row0 + tt) * LDZ; const float zb = bf2f(Z[r + 2048 + h]), za = bf2f(Z[r + 2052 + h]) + p.in[I_DTB][h];
        const float sp = za > 20.f ? za : log1pf(__expf(za)); meta[tt * 4] = __expf(-__expf(p.in[I_ALOG][h]) * sp); meta[tt * 4 + 1] = sigmoidf_(zb); }
#pragma unroll
    for (int i = 0; i < 8; ++i) *(f32x4*)(Ssh + (size_t)(i * 512 + tid) * 4) = st[i];
    __syncthreads();
    {
        const int tt = wid; const float q0 = qs[tt * 128 + lane], q1 = qs[tt * 128 + 64 + lane], k0 = ks[tt * 128 + lane], k1 = ks[tt * 128 + 64 + lane];
        const float sq = rsqrtf(wave_sum(q0 * q0 + q1 * q1) + EPSF) * 0.08838834764831845f, sk = rsqrtf(wave_sum(k0 * k0 + k1 * k1) + EPSF);
        const float kq = wave_sum(q0 * k0 + q1 * k1) * sq * sk;
        qs[tt * 128 + lane] = q0 * sq; qs[tt * 128 + 64 + lane] = q1 * sq; ks[tt * 128 + lane] = k0 * sk; ks[tt * 128 + 64 + lane] = k1 * sk;
        if (lane == 0) meta[tt * 4 + 2] = kq;
    }
    __syncthreads();
    const int part = lane & 15, cl = lane >> 4;
    for (int pp = 0; pp < 4; ++pp) {
        const int col = pp * 32 + wid * 4 + cl; float S[8];
#pragma unroll
        for (int i = 0; i < 8; ++i) { const int d = (i >> 2) * 64 + part * 4 + (i & 3); S[i] = Ssh[d * 128 + col]; }
#pragma unroll
        for (int tt = 0; tt < 8; ++tt) {
            const f32x4 ka = *(const f32x4*)(ks + tt * 128 + part * 4), kb = *(const f32x4*)(ks + tt * 128 + 64 + part * 4);
            const f32x4 qa = *(const f32x4*)(qs + tt * 128 + part * 4), qb = *(const f32x4*)(qs + tt * 128 + 64 + part * 4);
            const f32x4 mt = *(const f32x4*)(meta + tt * 4); const float v = vs[tt * 128 + col];
            float d1 = ((S[0] * ka[0] + S[1] * ka[1]) + (S[2] * ka[2] + S[3] * ka[3])) + ((S[4] * kb[0] + S[5] * kb[1]) + (S[6] * kb[2] + S[7] * kb[3]));
            float d2 = ((S[0] * qa[0] + S[1] * qa[1]) + (S[2] * qa[2] + S[3] * qa[3])) + ((S[4] * qb[0] + S[5] * qb[1]) + (S[6] * qb[2] + S[7] * qb[3]));
            d1 = row16_sum(d1); d2 = row16_sum(d2);
            const float a = mt[0], uu = mt[1] * (v - a * d1);
#pragma unroll
            for (int e = 0; e < 4; ++e) { S[e] = a * S[e] + ka[e] * uu; S[4 + e] = a * S[4 + e] + kb[e] * uu; }
            if (part == 0) ORAW[(size_t)(row0 + tt) * 512 + h * 128 + col] = a * d2 + uu * mt[2];
        }
#pragma unroll
        for (int i = 0; i < 8; ++i) { const int d = (i >> 2) * 64 + part * 4 + (i & 3); Ssh[d * 128 + col] = S[i]; }
    }
    __syncthreads();
    float* sout = p.out + O_DELTA_S + (size_t)(b * 4 + h) * 128 * 128;
#pragma unroll
    for (int i = 0; i < 8; ++i) *(f32x4*)(sout + (size_t)(i * 512 + tid) * 4) = *(const f32x4*)(Ssh + (size_t)(i * 512 + tid) * 4);
}

__device__ __forceinline__ void phase2a(int wv, const Params& p, float* smem) {
    const int nb = gridDim.x, bid = blockIdx.x;
    for (int it = bid; it < 256; it += nb) { const int bh = it >> 3, sl = it & 7; delta_prompt_item(wv, p, smem, bh >> 2, bh & 3, sl * 16); }
    for (int it = bid; it < 512; it += nb) delta_sample_item(wv, p, smem, it >> 2, it & 3);
}


__device__ __forceinline__ void sgu_prompt_item(int wv, const Params& p, float* smem, int b, int nch, int g0) {
    const int tid = opaque_tid(wv), lane = tid & 63, wid = tid >> 6;
    const bf16_t* Z = (const bf16_t*)(p.ws + WS_BIG); bf16_t* Mix = (bf16_t*)(p.ws + WS_Y);
    bf16_t* vT = (bf16_t*)smem; float* st = smem + 16384;
    const int row0 = b * 2048 + nch * 128;
    const int fr = lane & 15, fq = lane >> 4, nks = (wid >> 1) + 1;
    __syncthreads();
    {
        u32x4 raw16[16];
#pragma unroll
        for (int k = 0; k < 16; ++k) raw16[k] = *(const u32x4*)(Z + (size_t)(row0 + wid * 16 + k) * LDZ + 2568 + lane * 8);
#pragma unroll
        for (int hb = 0; hb < 2; ++hb) {
            u32x4 raw[8];
#pragma unroll
            for (int k = 0; k < 8; ++k) raw[k] = raw16[hb * 8 + k];
#pragma unroll
            for (int k = 0; k < 8; ++k) { float x[8];
#pragma unroll
                for (int i = 0; i < 4; ++i) { x[2 * i] = geluf_(__uint_as_float(raw[k][i] << 16)); x[2 * i + 1] = geluf_(__uint_as_float(raw[k][i] & 0xffff0000u)); }
                float sm = 0.f;
#pragma unroll
                for (int i = 0; i < 8; ++i) sm += x[i];
                const float mean = wave_sum(sm) * (1.0f / 512.0f); float q = 0.f;
#pragma unroll
                for (int i = 0; i < 8; ++i) { const float d = x[i] - mean; q += d * d; }
                const float var = wave_sum(q) * (1.0f / 512.0f);
                if (lane == 0) { const int t = wid * 16 + hb * 8 + k; st[t * 2] = mean; st[t * 2 + 1] = rsqrtf(var + EPSF); } }
        }
    }
    __syncthreads();
    for (int g = g0; g < g0 + 2; ++g) {
    bf16x8 wf[4];
    {   const float* wrow = p.in[I_WSP] + ((size_t)g * 128 + wid * 16 + fr) * 128; const int t = wid * 16 + fr;
#pragma unroll
        for (int ks = 0; ks < 4; ++ks) { unsigned w4[4] = {0u, 0u, 0u, 0u};
            if (ks < nks) { const int s0 = ks * 32 + fq * 8; const f32x4 a = *(const f32x4*)(wrow + s0), c4 = *(const f32x4*)(wrow + s0 + 4); float x[8] = {a[0], a[1], a[2], a[3], c4[0], c4[1], c4[2], c4[3]};
#pragma unroll
                for (int e = 0; e < 8; ++e) if (s0 + e > t) x[e] = 0.f;
#pragma unroll
                for (int e = 0; e < 4; ++e) w4[e] = pk2(x[2 * e], x[2 * e + 1]); }
            wf[ks] = __builtin_bit_cast(bf16x8, (u32x4){w4[0], w4[1], w4[2], w4[3]}); }
    }
    {
        const int cv = tid & 15; float lg8[8], lb8[8];
#pragma unroll
        for (int e = 0; e < 8; ++e) { lg8[e] = p.in[I_LNG][g * 128 + cv * 8 + e]; lb8[e] = p.in[I_LNB][g * 128 + cv * 8 + e]; }
        u32x4 raw[4];
#pragma unroll
        for (int j = 0; j < 4; ++j) { const int sI = (tid + j * 512) >> 4; raw[j] = *(const u32x4*)(Z + (size_t)(row0 + sI) * LDZ + 2568 + g * 128 + cv * 8); }
#pragma unroll
        for (int j = 0; j < 4; ++j) { const int sI = (tid + j * 512) >> 4; const float mean = st[sI * 2], rs = st[sI * 2 + 1]; float v[8];
#pragma unroll
            for (int i = 0; i < 4; ++i) { v[2 * i] = geluf_(__uint_as_float(raw[j][i] << 16)); v[2 * i + 1] = geluf_(__uint_as_float(raw[j][i] & 0xffff0000u)); }
#pragma unroll
            for (int e = 0; e < 8; ++e) v[e] = (v[e] - mean) * rs * lg8[e] + lb8[e];
#pragma unroll
            for (int e = 0; e < 8; ++e) vT[(cv * 8 + e) * 136 + sI] = f2bf(v[e]);
            if (nch == 15) { float* ov = p.out + O_SGUV_P + ((size_t)b * 128 + sI) * 512 + g * 128 + cv * 8; *(f32x4*)ov = (f32x4){v[0], v[1], v[2], v[3]}; *(f32x4*)(ov + 4) = (f32x4){v[4], v[5], v[6], v[7]}; } }
    }
    __syncthreads();
    {
        const int t = wid * 16 + fr; const float bs = p.in[I_BSP][g * 128 + t];
        u32x2 ur[8];
#pragma unroll
        for (int ct = 0; ct < 8; ++ct) ur[ct] = *(const u32x2*)(Z + (size_t)(row0 + t) * LDZ + 2056 + g * 128 + ct * 16 + fq * 4);
#pragma unroll
        for (int ct = 0; ct < 8; ++ct) { f32x4 acc = {0.f, 0.f, 0.f, 0.f};
#pragma unroll
            for (int ks = 0; ks < 4; ++ks) if (ks < nks) { const bf16x8 vf = *(const bf16x8*)(vT + (ct * 16 + fr) * 136 + ks * 32 + fq * 8); acc = __builtin_amdgcn_mfma_f32_16x16x32_bf16(vf, wf[ks], acc, 0, 0, 0); }
            const f32x4 u = bf4_to_f(ur[ct]); f32x4 o;
#pragma unroll
            for (int e = 0; e < 4; ++e) o[e] = geluf_(u[e]) * (acc[e] + bs);
            u32x2 w; w.x = pk2(o[0], o[1]); w.y = pk2(o[2], o[3]); *(u32x2*)(Mix + (size_t)(row0 + t) * 1024 + 512 + g * 128 + ct * 16 + fq * 4) = w; }
    }
    __syncthreads();
    }
}

__device__ __forceinline__ void sgu_sample_item(int wv, const Params& p, float* smem, int b) {
    const int tid = opaque_tid(wv), lane = tid & 63, wid = tid >> 6;
    const bf16_t* Z = (const bf16_t*)(p.ws + WS_BIG); bf16_t* Mix = (bf16_t*)(p.ws + WS_Y);
    float* vS = smem;
    const int row0 = MP + b * 8;
    __syncthreads();
    {   const int t = wid; const u32x4 raw = *(const u32x4*)(Z + (size_t)(row0 + t) * LDZ + 2568 + lane * 8); float x[8];
#pragma unroll
        for (int i = 0; i < 4; ++i) { x[2 * i] = geluf_(__uint_as_float(raw[i] << 16)); x[2 * i + 1] = geluf_(__uint_as_float(raw[i] & 0xffff0000u)); }
        float s = 0.f;
#pragma unroll
        for (int i = 0; i < 8; ++i) s += x[i];
        const float mean = wave_sum(s) * (1.0f / 512.0f); float q = 0.f;
#pragma unroll
        for (int i = 0; i < 8; ++i) { const float d = x[i] - mean; q += d * d; }
        const float rs = rsqrtf(wave_sum(q) * (1.0f / 512.0f) + EPSF);
#pragma unroll
        for (int i = 0; i < 8; ++i) { const int ch = lane * 8 + i; const float v = (x[i] - mean) * rs * p.in[I_LNG][ch] + p.in[I_LNB][ch]; vS[t * 512 + ch] = v; p.out[O_SGUV_S + ((size_t)b * 8 + t) * 512 + ch] = v; }
    }
    __syncthreads();
    const int ch = tid, g = ch >> 7; const float* wsp = p.in[I_WSP] + (size_t)g * 128 * 128; const float* bsp = p.in[I_BSP] + g * 128;
    bf16_t uraw[8];
#pragma unroll
    for (int t = 0; t < 8; ++t) uraw[t] = Z[(size_t)(row0 + t) * LDZ + 2056 + ch];
#pragma unroll
    for (int t = 0; t < 8; ++t) { float a = bsp[t];
#pragma unroll
        for (int s = 0; s <= t; ++s) a += wsp[t * 128 + s] * vS[s * 512 + ch];
        const float u = geluf_(bf2f(uraw[t]));
        Mix[(size_t)(row0 + t) * 1024 + 512 + ch] = f2bf(u * a); }
}

__device__ __forceinline__ void convert_p(int wv, const Params& p, int layer, bf16_t* dst, int vb, int nvb) {
    const float* pp = p.in[I_PP] + (size_t)layer * MP * 256; const float* ps = p.in[I_PS] + (size_t)layer * 1024 * 256;
    const size_t str_ = (size_t)nvb * 512, tot_ = (size_t)MROWS * 64;
    for (size_t i0 = (size_t)vb * 512 + opaque_tid(wv); i0 < tot_; i0 += 4 * str_) {
        f32x4 v[4];
#pragma unroll
        for (int k = 0; k < 4; ++k) { const size_t i = i0 + k * str_ < tot_ ? i0 + k * str_ : i0, e = i * 4; v[k] = e < (size_t)MP * 256 ? *(const f32x4*)(pp + e) : *(const f32x4*)(ps + (e - (size_t)MP * 256)); }
#pragma unroll
        for (int k = 0; k < 4; ++k) { const size_t i = i0 + k * str_; if (i < tot_) { u32x2 w; w.x = pk2(v[k][0], v[k][1]); w.y = pk2(v[k][2], v[k][3]); *(u32x2*)(dst + i * 4) = w; } }
    }
}

__device__ __forceinline__ void phase2b(int wv, const Params& p, float* smem) {
    const int tid = opaque_tid(wv), lane = tid & 63, nb = gridDim.x, bid = blockIdx.x, gw = bid * 8 + (tid >> 6), nw = nb * 8;
    const bf16_t* Z = (const bf16_t*)(p.ws + WS_BIG); bf16_t* Mix = (bf16_t*)(p.ws + WS_Y); const float* ORAW = (const float*)(p.ws + WS_X);
    {
        const float no0 = p.in[I_NORMO][lane * 2], no1 = p.in[I_NORMO][lane * 2 + 1];
        float n0[8], n1[8]; unsigned nz[8];
        auto fetch = [&](int row) {
#pragma unroll
            for (int k = 0; k < 8; ++k) { const int r = row + (k >> 2), c = (k & 3) * 128 + lane * 2; const float* op = ORAW + (size_t)r * 512 + c; n0[k] = op[0]; n1[k] = op[1]; nz[k] = *(const unsigned*)(Z + (size_t)r * LDZ + 1536 + c); } };
        if (gw * 2 < MROWS) fetch(gw * 2);
        for (int row = gw * 2; row < MROWS; row += nw * 2) {
            float o0[8], o1[8]; unsigned zg[8];
#pragma unroll
            for (int k = 0; k < 8; ++k) { o0[k] = n0[k]; o1[k] = n1[k]; zg[k] = nz[k]; }
            if (row + nw * 2 < MROWS) fetch(row + nw * 2);
#pragma unroll
            for (int k = 0; k < 8; ++k) { const int r = row + (k >> 2), c = (k & 3) * 128 + lane * 2;
                const float rs = rsqrtf(wave_sum(o0[k] * o0[k] + o1[k] * o1[k]) * (1.0f / 128.0f) + EPSF);
                const float g0 = siluf_(__uint_as_float(zg[k] << 16)), g1 = siluf_(__uint_as_float(zg[k] & 0xffff0000u));
                *(unsigned*)(Mix + (size_t)r * 1024 + c) = pk2(o0[k] * rs * no0 * g0, o1[k] * rs * no1 * g1); }
        }
    }
    for (int i = bid * 512 + tid; i < 8 * 3 * 1536; i += nb * 512) { const int c = i % 1536, r = (i / 1536) % 3, b = i / (3 * 1536); p.out[O_CONV_P + i] = bf2f(Z[(size_t)(b * 2048 + 2045 + r) * LDZ + c]); }
    for (int i0 = bid * 512 + tid; i0 < 128 * 3 * 1536; i0 += 4 * nb * 512) { bf16_t v[4];
#pragma unroll
        for (int k = 0; k < 4; ++k) { const int i = i0 + k * nb * 512 < 128 * 3 * 1536 ? i0 + k * nb * 512 : i0, c = i % 1536, r = (i / 1536) % 3, b = i / (3 * 1536); v[k] = Z[(size_t)(MP + b * 8 + 5 + r) * LDZ + c]; }
#pragma unroll
        for (int k = 0; k < 4; ++k) { const int i = i0 + k * nb * 512; if (i < 128 * 3 * 1536) p.out[O_CONV_S + i] = bf2f(v[k]); } }
    for (int it = bid; it < 256; it += nb) sgu_prompt_item(wv, p, smem, it >> 5, (it >> 1) & 15, (it & 1) * 2);
    for (int it = bid; it < 128; it += nb) sgu_sample_item(wv, p, smem, it);
}

template <bool PROMPT>
__device__ __forceinline__ void s5_item(const Params& p, float* wl  , float* exch  , int wid, int b, int g) {
    constexpr bool sample = !PROMPT;
    const int lane = lane_id_(), lr16 = lane & 15, lq = lane >> 4;
    const float* Z1 = (const float*)(p.ws + WS_BIG + BIG_Z1); bf16_t* YG = (bf16_t*)(p.ws + WS_BIG + BIG_YG);
    float* buL = wl; float* sL = wl + 16 * 132;
    int row0 = sample ? MP + b * 8 : b * 2048;
    const float dt = __expf(p.in[I_LOGDT][g]);
    const float* lamre = p.in[I_LAMRE] + g * 64; const float* lamim = p.in[I_LAMIM] + g * 64;
    float lbr, lbi;
    { const float x = lamre[lane] * dt, y = lamim[lane] * dt, ex = __expf(x); float sn, cs; sincosf(y, &sn, &cs); lbr = ex * cs; lbi = ex * sn; }
    float sr = 0.f, si = 0.f;
    if (sample) { sr = p.in[I_S5RE][((size_t)b * 32 + g) * 64 + lane]; si = p.in[I_S5IM][((size_t)b * 32 + g) * 64 + lane]; }
    bf16x8 bfr[8];
    {
        float fre[4], fim[4];
#pragma unroll
        for (int j = 0; j < 4; ++j) { const int nn = j * 16 + lr16; const float lr = lamre[nn], li = lamim[nn], x = lr * dt, y = li * dt; float sn, cs; sincosf(y, &sn, &cs);
            const float ex = __expf(x), em = expm1f(x), sh = sinf(0.5f * y); const float re1 = em * cs - 2.f * sh * sh, im1 = ex * sn, den = 1.0f / (lr * lr + li * li);
            fre[j] = (re1 * lr + im1 * li) * den; fim[j] = (im1 * lr - re1 * li) * den; }
#pragma unroll
        for (int j = 0; j < 8; ++j) { const int nn = (j & 3) * 16 + lr16; const bool im = j >= 4; unsigned w[4] = {0u, 0u, 0u, 0u};
            if (lq < 2) { const float* br = p.in[I_BRE] + ((size_t)g * 64 + nn) * 16 + lq * 8; const float* bi = p.in[I_BIM] + ((size_t)g * 64 + nn) * 16 + lq * 8; float v[8];
#pragma unroll
                for (int i = 0; i < 8; ++i) v[i] = im ? (fre[j & 3] * bi[i] + fim[j & 3] * br[i]) : (fre[j & 3] * br[i] - fim[j & 3] * bi[i]);
#pragma unroll
                for (int i = 0; i < 4; ++i) w[i] = pk2(v[2 * i], v[2 * i + 1]); }
            bfr[j] = __builtin_bit_cast(bf16x8, (u32x4){w[0], w[1], w[2], w[3]}); }
    }
    bf16x8 cfr[4];
#pragma unroll
    for (int kk = 0; kk < 4; ++kk) { const int n0 = kk * 32 + lq * 8; const float* src = (n0 < 64 ? p.in[I_CRE] : p.in[I_CIM]) + ((size_t)g * 16 + lr16) * 64 + (n0 & 63); const float sg = n0 < 64 ? 1.f : -1.f; unsigned w[4];
#pragma unroll
        for (int i = 0; i < 4; ++i) w[i] = pk2(sg * src[2 * i], sg * src[2 * i + 1]);
        cfr[kk] = __builtin_bit_cast(bf16x8, (u32x4){w[0], w[1], w[2], w[3]}); }
    const float dsk = p.in[I_DSKIP][g * 16 + lr16];
    auto run = [&](const int t_lo, const int T, const bool yout) {
    f32x4 pa = {0.f, 0.f, 0.f, 0.f}, pc = {0.f, 0.f, 0.f, 0.f}; float pu[4] = {0.f, 0.f, 0.f, 0.f};
    auto fetch = [&](int t0) {
        const int nv = (T - t0) < 16 ? (T - t0) : 16;
        pa = (f32x4){0.f, 0.f, 0.f, 0.f}; pc = pa;
        if (lq < 2 && lr16 < nv) { const float* up = Z1 + (size_t)(row0 + t0 + lr16) * 1024 + 512 + g * 16 + lq * 8; pa = *(const f32x4*)up; pc = *(const f32x4*)(up + 4); }
#pragma unroll
        for (int jj = 0; jj < 4; ++jj) { const int tok = lq * 4 + jj; pu[jj] = tok < nv ? Z1[(size_t)(row0 + t0 + tok) * 1024 + 512 + g * 16 + lr16] : 0.f; }
    };
    fetch(t_lo);
    for (int t0 = t_lo; t0 < T; t0 += 16) {
        const int nv = (T - t0) < 16 ? (T - t0) : 16;
        const bf16x8 afr = __builtin_bit_cast(bf16x8, (u32x4){pk2(pa[0], pa[1]), pk2(pa[2], pa[3]), pk2(pc[0], pc[1]), pk2(pc[2], pc[3])});
        float ucur[4];
#pragma unroll
        for (int jj = 0; jj < 4; ++jj) ucur[jj] = pu[jj];
        if (t0 + 16 < T) fetch(t0 + 16);
#pragma unroll
        for (int j = 0; j < 8; ++j) { f32x4 acc = {0.f, 0.f, 0.f, 0.f}; acc = __builtin_amdgcn_mfma_f32_16x16x32_bf16(afr, bfr[j], acc, 0, 0, 0);
#pragma unroll
            for (int jj = 0; jj < 4; ++jj) buL[(lq * 4 + jj) * 132 + j * 16 + lr16] = acc[jj]; }
        asm volatile("s_waitcnt lgkmcnt(0)" ::: "memory");
        if (nv == 16) {
            float br_[16], bi_[16];
#pragma unroll
            for (int tt = 0; tt < 16; ++tt) { br_[tt] = buL[tt * 132 + lane]; bi_[tt] = buL[tt * 132 + 64 + lane]; }
#pragma unroll
            for (int tt = 0; tt < 16; ++tt) { const float nr = lbr * sr - lbi * si + br_[tt], ni = lbr * si + lbi * sr + bi_[tt]; sr = nr; si = ni;
                sL[tt * 132 + lane] = nr; sL[tt * 132 + 64 + lane] = ni; }
        } else {
            for (int tt = 0; tt < nv; ++tt) { const float bur = buL[tt * 132 + lane], bui = buL[tt * 132 + 64 + lane];
                const float nr = lbr * sr - lbi * si + bur, ni = lbr * si + lbi * sr + bui; sr = nr; si = ni;
                sL[tt * 132 + lane] = nr; sL[tt * 132 + 64 + lane] = ni; }
        }
        asm volatile("s_waitcnt lgkmcnt(0)" ::: "memory");
        if (!yout) continue;
        f32x4 yacc = {0.f, 0.f, 0.f, 0.f};
#pragma unroll
        for (int kk = 0; kk < 4; ++kk) { const float* sp = sL + lr16 * 132 + kk * 32 + lq * 8; const f32x4 a = *(const f32x4*)sp, c4 = *(const f32x4*)(sp + 4);
            const bf16x8 sfr = __builtin_bit_cast(bf16x8, (u32x4){pk2(a[0], a[1]), pk2(a[2], a[3]), pk2(c4[0], c4[1]), pk2(c4[2], c4[3])});
            yacc = __builtin_amdgcn_mfma_f32_16x16x32_bf16(sfr, cfr[kk], yacc, 0, 0, 0); }
#pragma unroll
        for (int jj = 0; jj < 4; ++jj) { const int tok = lq * 4 + jj;
            if (tok < nv) YG[(size_t)(row0 + t0 + tok) * 512 + g * 16 + lr16] = f2bf(geluf_(yacc[jj] + dsk * ucur[jj])); }
        asm volatile("s_waitcnt lgkmcnt(0)" ::: "memory");
    }
    };
    float* ore = p.out + (sample ? O_S5RE_S : O_S5RE_P) + ((size_t)b * 32 + g) * 64; float* oim = p.out + (sample ? O_S5IM_S : O_S5IM_P) + ((size_t)b * 32 + g) * 64;
    if (!PROMPT) {
        for (int bb = b; bb < 128; bb += 64) {
            row0 = MP + bb * 8; sr = p.in[I_S5RE][((size_t)bb * 32 + g) * 64 + lane]; si = p.in[I_S5IM][((size_t)bb * 32 + g) * 64 + lane];
            run(0, 8, true);
            p.out[O_S5RE_S + ((size_t)bb * 32 + g) * 64 + lane] = sr; p.out[O_S5IM_S + ((size_t)bb * 32 + g) * 64 + lane] = si; }
    }
    else {
        const int t_lo = wid * 256;
        run(t_lo, t_lo + 256, false);
        exch[wid * 128 + lane] = sr; exch[wid * 128 + 64 + lane] = si;
        __syncthreads();
        float pr = lbr, pi = lbi;
#pragma unroll
        for (int i = 0; i < 8; ++i) { const float nr = pr * pr - pi * pi, ni = 2.f * pr * pi; pr = nr; pi = ni; }
        float cr = 0.f, ci = 0.f;
        for (int j = 0; j < wid; ++j) { const float er = exch[j * 128 + lane], ei = exch[j * 128 + 64 + lane]; const float nr = pr * cr - pi * ci + er, ni = pr * ci + pi * cr + ei; cr = nr; ci = ni; }
        sr = cr; si = ci;
        run(t_lo, t_lo + 256, true);
        if (wid == 7) { ore[lane] = sr; oim[lane] = si; }
        __syncthreads();
    }
}

template <int WIN, int RB>
__device__ __forceinline__ void pool_item(const Params& p, const float* Z1, bf16_t* Mix, bool smp, int b, int t0, int rbase, int c) {
    constexpr int NR = WIN - 1 + RB;
    float x[NR];
#pragma unroll
    for (int r = 0; r < NR; ++r) { const int tp = t0 - (WIN - 1) + r;
        const float* src = tp >= 0 ? Z1 + (size_t)(rbase + tp) * 1024 + c : (smp ? p.in[I_SPOOL] + ((size_t)b * 15 + 15 + tp) * 512 + c : Z1 + (size_t)rbase * 1024 + c);
        const float v = *src; x[r] = (tp >= 0 || smp) ? v : 0.f; }
    float run = 0.f;
#pragma unroll
    for (int r = 0; r < WIN - 1; ++r) run += x[r];
#pragma unroll
    for (int j = 0; j < RB; ++j) { run += x[WIN - 1 + j]; const int t = t0 + j; const float cnt = smp ? (float)WIN : (float)((t + 1) < WIN ? (t + 1) : WIN);
        Mix[(size_t)(rbase + t) * 1024 + c] = f2bf(run / cnt - x[WIN - 1 + j]); run -= x[j]; }
}

__device__ __forceinline__ void pool_work(const Params& p, int lane, int hw, int nh) {
    const float* Z1 = (const float*)(p.ws + WS_BIG + BIG_Z1); bf16_t* Mix = (bf16_t*)(p.ws + WS_Y);
    for (int it = hw; it < 1024 * 8; it += nh) { const int blk = it >> 3, ck = it & 7, c = ck * 64 + lane, gi = ck >> 1, b = blk >> 7, t0 = (blk & 127) * 16, rbase = b * 2048;
        if (gi == 0) pool_item<2, 16>(p, Z1, Mix, false, b, t0, rbase, c); else if (gi == 1) pool_item<4, 16>(p, Z1, Mix, false, b, t0, rbase, c);
        else if (gi == 2) pool_item<8, 16>(p, Z1, Mix, false, b, t0, rbase, c); else pool_item<16, 16>(p, Z1, Mix, false, b, t0, rbase, c); }
    for (int it = hw; it < 128 * 8; it += nh) { const int b = it >> 3, ck = it & 7, c = ck * 64 + lane, gi = ck >> 1, rbase = MP + b * 8;
        if (gi == 0) pool_item<2, 8>(p, Z1, Mix, true, b, 0, rbase, c); else if (gi == 1) pool_item<4, 8>(p, Z1, Mix, true, b, 0, rbase, c);
        else if (gi == 2) pool_item<8, 8>(p, Z1, Mix, true, b, 0, rbase, c); else pool_item<16, 8>(p, Z1, Mix, true, b, 0, rbase, c); }
    for (int i = hw * 64 + lane; i < 8 * 15 * 512; i += nh * 64) { const int c = i & 511, r = (i >> 9) % 15, b = i / (15 * 512); p.out[O_POOL_P + i] = Z1[(size_t)(b * 2048 + 2033 + r) * 1024 + c]; }
    for (int i = hw * 64 + lane; i < 128 * 15 * 512; i += nh * 64) { const int c = i & 511, r = (i >> 9) % 15, b = i / (15 * 512);
        p.out[O_POOL_S + i] = r < 7 ? p.in[I_SPOOL][((size_t)b * 15 + r + 8) * 512 + c] : Z1[(size_t)(MP + b * 8 + r - 7) * 1024 + c]; }
}

__device__ __forceinline__ void phase8a(int wv, const Params& p, float* smem, bool pool_in_glu) {
    const int tid = opaque_tid(wv), lane = tid & 63, wid = __builtin_amdgcn_readfirstlane(tid >> 6), nb = gridDim.x, bid = blockIdx.x;
    float* wl = smem + wid * (2 * 16 * 132);
    const float* Z1 = (const float*)(p.ws + WS_BIG + BIG_Z1); bf16_t* Mix = (bf16_t*)(p.ws + WS_Y);
    float* exch = smem + 8 * (2 * 16 * 132);
    for (int it = bid; it < 256; it += nb) s5_item<true>(p, wl, exch, wid, it >> 5, it & 31);
    const int hw = bid * 8 + wid, nh = nb * 8;
    for (int it = hw; it < 2048; it += nh) s5_item<false>(p, wl, exch, wid, it >> 5, it & 31);
    if (!pool_in_glu) pool_work(p, lane, hw, nh);
}

#define XB_TMO      128
#define XB_XCNT(j)  (256  + 64 * (j))
#define XB_XSUB(j)  (1280 + 64 * (j))
#define XB_XGEN(j)  (2304 + 64 * (j))
#define XB_TOP      3328
#define XB_TOPGEN   3392
#define XB_SPIN_CAP (1u << 22)
__device__ __forceinline__ unsigned xb_ld(unsigned* p)              { return __hip_atomic_load(p, __ATOMIC_RELAXED, __HIP_MEMORY_SCOPE_AGENT); }
__device__ __forceinline__ unsigned xb_add(unsigned* p, unsigned v) { return __hip_atomic_fetch_add(p, v, __ATOMIC_RELAXED, __HIP_MEMORY_SCOPE_AGENT); }
__device__ __forceinline__ unsigned xb_xcc_id() { return (unsigned)__builtin_amdgcn_s_getreg((3 << 11) | 20) & 0xFu; }
#define XB_SPIN(cond, bar) do { unsigned _sp = 0; while (cond) { __builtin_amdgcn_s_sleep(1); \
    if ((++_sp & 255u) == 0u) { if (xb_ld(&(bar)[XB_TMO])) break; if (_sp > XB_SPIN_CAP) { atomicAdd(&(bar)[XB_TMO], 1u); break; } } } } while (0)
__device__ __forceinline__ void xcd_barrier_complete(unsigned* bar, unsigned x, unsigned& nloc, unsigned& nx) {
    const unsigned G = gridDim.x;
    unsigned sum, cnt, mine, sp = 0u;
    for (;;) {
        sum = 0u; cnt = 0u; mine = 0u;
#pragma unroll
        for (unsigned j = 0; j < 16; ++j) { const unsigned c = xb_ld(&bar[XB_XCNT(j)]); sum += c; cnt += (c > 0u) ? 1u : 0u; mine = (j == x) ? c : mine; }
        if (sum == G) break;
        __builtin_amdgcn_s_sleep(1);
        if ((++sp & 255u) == 0u) { if (xb_ld(&bar[XB_TMO])) break; if (sp > XB_SPIN_CAP) { atomicAdd(&bar[XB_TMO], 1u); break; } }
    }
    nloc = mine > 0u ? mine : 1u; nx = cnt > 0u ? cnt : 1u;
}
__device__ __forceinline__ void grid_bar(unsigned* bar, volatile PG8_LAS unsigned* st) {
    asm volatile("s_waitcnt vmcnt(0) lgkmcnt(0)" ::: "memory");
    __syncthreads();
    if (threadIdx.x == 0) {
        const unsigned x = xb_xcc_id();
        unsigned nloc = st[0], nx = st[1];
        if (nloc == 0u) { xcd_barrier_complete(bar, x, nloc, nx); st[0] = nloc; st[1] = nx; }
        const unsigned old = xb_add(&bar[XB_XSUB(x)], 1u);
        const unsigned gen = old / nloc;
        if (old + 1u == (gen + 1u) * nloc) {
            __builtin_amdgcn_fence(__ATOMIC_RELEASE, "agent");
            asm volatile("s_waitcnt vmcnt(0)" ::: "memory");
            const unsigned og = xb_add(&bar[XB_TOP], 1u);
            const unsigned tg = og / nx;
            if (og + 1u == (tg + 1u) * nx) xb_add(&bar[XB_TOPGEN], 1u);
            else XB_SPIN(xb_ld(&bar[XB_TOPGEN]) == tg, bar);
            __builtin_amdgcn_fence(__ATOMIC_ACQUIRE, "agent");
            xb_add(&bar[XB_XGEN(x)], 1u);
            asm volatile("s_waitcnt vmcnt(0)" ::: "memory");
        } else {
            XB_SPIN(xb_ld(&bar[XB_XGEN(x)]) == gen, bar);
            __builtin_amdgcn_fence(__ATOMIC_ACQUIRE, "agent");
            asm volatile("s_waitcnt vmcnt(0)" ::: "memory");
        }
    }
    __syncthreads();
}
#ifndef PROBE_GROUP
#define PROBE_GROUP 0
#endif
#define TB(g) do { if (PROBE_GROUP == (g)) t0_ = __builtin_amdgcn_s_memrealtime(); } while (0)
#define TE(g) do { if (PROBE_GROUP == (g)) tacc_ += __builtin_amdgcn_s_memrealtime() - t0_; } while (0)
__global__ void __launch_bounds__(512) fwd_megakernel(Params p) {
    extern __shared__ __attribute__((aligned(16))) unsigned char dynlds[];
    cg::grid_group grid = cg::this_grid();
    PG8_LAS unsigned char* lds = (PG8_LAS unsigned char*)dynlds;
    float* smem = (float*)dynlds;
    unsigned char* ws = p.ws;
    bf16_t* WB = (bf16_t*)(ws + WS_WB); bf16_t* X = (bf16_t*)(ws + WS_X); bf16_t* Y = (bf16_t*)(ws + WS_Y); float* ss = (float*)(ws + WS_SS);
    bf16_t* BIGb = (bf16_t*)(ws + WS_BIG);
    float* H = p.out + O_Y;

    const int wv = __builtin_amdgcn_readfirstlane((int)threadIdx.x >> 6);
    unsigned long long t0_ = 0, tacc_ = 0;
    const bool pool_in_glu = gridDim.x >= 200u;
    unsigned* gbar = (unsigned*)(ws + WS_BAR); volatile PG8_LAS unsigned* xbst = (volatile PG8_LAS unsigned*)(lds + LDS_XB);
    if (threadIdx.x == 0) { xbst[0] = 0u; xbst[1] = 0u; (void)xb_add(&gbar[XB_XCNT(xb_xcc_id())], 1u); }
#define GSYNC() grid_bar(gbar, xbst)
    if (p.out == nullptr) grid.sync();
    TB(1); phase0(wv, p, smem);
    GSYNC(); TE(1);
    TB(5);
    run_gemm(wv, lds, X, WB + WO_IN_AB, MROWS, LDZ, 1024, EpiZ{BIGb, LDZ, ss});
    for (;;) {
        volatile PG8_LAS unsigned* shw = (volatile PG8_LAS unsigned*)(lds + LDS_XB + 16);
        __syncthreads();
        if (threadIdx.x == 0) *shw = xb_add(&gbar[3500], 1u);
        __syncthreads();
        const unsigned vb = *shw;
        if (vb >= 1024u) break;
        convert_rest(wv, p, smem, (int)vb, 1024);
    }
    GSYNC(); TE(5);
    TB(2); phase2p(wv, p, smem);
    GSYNC();
    phase2a(wv, p, smem);
    GSYNC(); TE(2);
    TB(3); phase2b(wv, p, smem);
    GSYNC(); TE(3);
    TB(6);
    { const QResF q{p.in[I_XP], p.in[I_XS], X}; run_gemm(wv, lds, Y, WB + WO_OUT_AB, MP, 1024, 1024, EpiQ<QResF, true>{q, ss + 1 * MROWS});
      tail_gemm<QResF, true>(wv, dynlds, Y + (size_t)MP * 1024, 1024, WB + WO_OUT_AB, 1024, 1024, q, ss + 1 * MROWS); }
    GSYNC(); TE(6);
    TB(7);
    { const QUp q{BIGb, ss + 1 * MROWS}; run_gemm(wv, lds, X, WB + WO_UP0, MP, DFF, 1024, EpiQ<QUp, false>{q, nullptr});
      tail_gemm<QUp, false, 2>(wv, dynlds, X + (size_t)MP * 1024, 1024, WB + WO_UP0, DFF, 1024, q, nullptr); }
    GSYNC(); TE(7);
    TB(8);
    { const QResB q{X, Y}; run_gemm(wv, lds, BIGb, WB + WO_DOWN0, MP, 1024, DFF, EpiQ<QResB, true>{q, ss + 2 * MROWS});
      tail_gemm<QResB, true>(wv, dynlds, BIGb + (size_t)MP * DFF, DFF, WB + WO_DOWN0, 1024, DFF, q, ss + 2 * MROWS); }
    convert_p(wv, p, 0, WB + WO_IN_AB, (int)blockIdx.x, (int)gridDim.x);
    GSYNC(); TE(8);
    TB(9);
    { const QGate qg{BIGb, ss + 2 * MROWS}; const QProj qp{BIGb, Y, X};
      run_gemm(wv, lds, Y, WB + WO_GATE0, MP, 1024, 1024, EpiQ<QGate, false>{qg, nullptr});
      tail_gemm<QGate, false>(wv, dynlds, Y + (size_t)MP * 1024, 1024, WB + WO_GATE0, 1024, 1024, qg, nullptr);
      asm volatile("s_waitcnt vmcnt(0)" ::: "memory"); __syncthreads();
      run_gemm(wv, lds, WB + WO_IN_AB, WB + WO_PROJ0, MP, 1024, 256, EpiQ<QProj, true>{qp, ss + 3 * MROWS});
      tail_gemm<QProj, true>(wv, dynlds, WB + WO_IN_AB + (size_t)MP * 256, 256, WB + WO_PROJ0, 1024, 256, qp, ss + 3 * MROWS); }
    GSYNC(); TE(9);
    TB(10);
    { const QZ1 q{(float*)(ws + WS_BIG + BIG_Z1), ss + 3 * MROWS}; run_gemm(wv, lds, X, WB + WO_IN_CD, MP, 1024, 1024, EpiQ<QZ1, false>{q, nullptr});
      tail_gemm<QZ1, false>(wv, dynlds, X + (size_t)MP * 1024, 1024, WB + WO_IN_CD, 1024, 1024, q, nullptr); }
    GSYNC(); TE(10);
    TB(4); phase8a(wv, p, smem, pool_in_glu);
    GSYNC(); TE(4);
    TB(11);
    run_gemm(wv, lds, (const bf16_t*)(ws + WS_BIG + BIG_YG), WB + WO_GLU, MROWS, 512, 512, EpiGlu{(const bf16_t*)(ws + WS_BIG + BIG_YG), p.in[I_BGLU], Y});
    if (pool_in_glu && (int)blockIdx.x >= 136) {
        const int ib = (int)blockIdx.x - 136, nib = (int)gridDim.x - 136, tidg = opaque_tid(wv);
        pool_work(p, tidg & 63, ib * 8 + (tidg >> 6), nib * 8);
        convert_p(wv, p, 1, WB + WO_UP0, ib, nib);
    }
    GSYNC(); TE(11);
    TB(6);
    { const QResB q{X, X}; run_gemm(wv, lds, Y, WB + WO_OUT_CD, MP, 1024, 1024, EpiQ<QResB, true>{q, ss + 4 * MROWS});
      tail_gemm<QResB, true>(wv, dynlds, Y + (size_t)MP * 1024, 1024, WB + WO_OUT_CD, 1024, 1024, q, ss + 4 * MROWS); }
    GSYNC(); TE(6);
    TB(7);
    { const QUp q{BIGb, ss + 4 * MROWS}; run_gemm(wv, lds, X, WB + WO_UP1, MP, DFF, 1024, EpiQ<QUp, false>{q, nullptr});
      tail_gemm<QUp, false, 2>(wv, dynlds, X + (size_t)MP * 1024, 1024, WB + WO_UP1, DFF, 1024, q, nullptr); }
    GSYNC(); TE(7);
    TB(8);
    { const QResB q{X, Y}; run_gemm(wv, lds, BIGb, WB + WO_DOWN1, MP, 1024, DFF, EpiQ<QResB, true>{q, ss + 5 * MROWS});
      tail_gemm<QResB, true>(wv, dynlds, BIGb + (size_t)MP * DFF, DFF, WB + WO_DOWN1, 1024, DFF, q, ss + 5 * MROWS); }
    if (!pool_in_glu) convert_p(wv, p, 1, WB + WO_UP0, (int)blockIdx.x, (int)gridDim.x);
    GSYNC(); TE(8);
    TB(9);
    { const QGate qg{BIGb, ss + 5 * MROWS}; const QProj qp{BIGb, Y, X};
      run_gemm(wv, lds, Y, WB + WO_GATE1, MP, 1024, 1024, EpiQ<QGate, false>{qg, nullptr});
      tail_gemm<QGate, false>(wv, dynlds, Y + (size_t)MP * 1024, 1024, WB + WO_GATE1, 1024, 1024, qg, nullptr);
      asm volatile("s_waitcnt vmcnt(0)" ::: "memory"); __syncthreads();
      run_gemm(wv, lds, WB + WO_UP0, WB + WO_PROJ1, MP, 1024, 256, EpiQ<QProj, true>{qp, ss + 6 * MROWS});
      tail_gemm<QProj, true>(wv, dynlds, WB + WO_UP0 + (size_t)MP * 256, 256, WB + WO_PROJ1, 1024, 256, qp, ss + 6 * MROWS); }
    GSYNC(); TE(9);
    {
        const int tidf = opaque_tid(wv), lane = tidf & 63, gw = blockIdx.x * 8 + (tidf >> 6), nw = gridDim.x * 8; const float* gf = p.in[I_NFINAL]; const float* s6 = ss + 6 * MROWS;
        f32x4 gq[4];
#pragma unroll
        for (int i = 0; i < 4; ++i) gq[i] = *(const f32x4*)(gf + (i * 64 + lane) * 4);
        for (int rowa = gw; rowa < MROWS; rowa += 4 * nw) {
            u32x2 xv[4][4]; float rs[4];
#pragma unroll
            for (int k = 0; k < 4; ++k) { const int row = rowa + k * nw < MROWS ? rowa + k * nw : rowa; rs[k] = rstd_of(s6, row);
#pragma unroll
                for (int i = 0; i < 4; ++i) xv[k][i] = *(const u32x2*)(X + (size_t)row * 1024 + (i * 64 + lane) * 4); }
#pragma unroll
            for (int k = 0; k < 4; ++k) { const int row = rowa + k * nw;
                if (row < MROWS) {
#pragma unroll
                    for (int i = 0; i < 4; ++i) *(f32x4*)(H + (size_t)row * 1024 + (i * 64 + lane) * 4) = bf4_to_f(xv[k][i]) * rs[k] * gq[i]; } }
        }
    }
    if (PROBE_GROUP != 0 && blockIdx.x == 0) { const unsigned long long ts = __builtin_amdgcn_s_memrealtime(); while (__builtin_amdgcn_s_memrealtime() - ts < tacc_) __builtin_amdgcn_s_sleep(8); }
}

extern "C" void kernel_launch(void* const* d_in, const int* in_sizes, int n_in, void* d_out, int out_size, void* d_ws, size_t ws_size, hipStream_t stream) {
    static int grid_blocks = 0;
    if (grid_blocks == 0) {
        if (n_in != NIN || (size_t)out_size != O_END || ws_size < WS_END) { fprintf(stderr, "kernel_launch: unexpected shapes n_in %d out %d ws %zu\n", n_in, out_size, ws_size); grid_blocks = -1; return; }
        int dev = 0, cus = 0, per_cu = 0;
        hipGetDevice(&dev);
        hipDeviceGetAttribute(&cus, hipDeviceAttributeMultiprocessorCount, dev);
        if (hipFuncSetAttribute((const void*)fwd_megakernel, hipFuncAttributeMaxDynamicSharedMemorySize, LDS_BYTES) != hipSuccess) { fprintf(stderr, "kernel_launch: hipFuncSetAttribute failed\n"); grid_blocks = -1; return; }
        if (hipOccupancyMaxActiveBlocksPerMultiprocessor(&per_cu, (const void*)fwd_megakernel, 512, LDS_BYTES) != hipSuccess || per_cu < 1) { fprintf(stderr, "kernel_launch: occupancy query failed (%d)\n", per_cu); per_cu = 1; (void)hipGetLastError(); }
        grid_blocks = cus * per_cu;
    }
    if (grid_blocks < 0) return;
    Params p{};
    for (int i = 0; i < NIN; ++i) p.in[i] = (const float*)d_in[i];
    p.out = (float*)d_out; p.ws = (unsigned char*)d_ws;
    if (hipMemsetAsync((char*)d_ws + WS_BAR, 0, 16384, stream) != hipSuccess) { fprintf(stderr, "kernel_launch: memset of the barrier word failed\n"); return; }
    void* args[] = {&p};
    hipError_t e = hipLaunchCooperativeKernel((const void*)fwd_megakernel, dim3(grid_blocks), dim3(512), args, LDS_BYTES, stream);
    if (e != hipSuccess) fprintf(stderr, "cooperative launch failed: %s (grid %d)\n", hipGetErrorString(e), grid_blocks);
}
```

```cpp
#include <hip/hip_runtime.h>
#include <hip/hip_cooperative_groups.h>
#include <cstdio>
namespace cg = cooperative_groups;

__device__ __forceinline__ int lane_id_() { return (int)__builtin_amdgcn_mbcnt_hi(~0u, __builtin_amdgcn_mbcnt_lo(~0u, 0u)); }
__device__ __forceinline__ int opaque_tid(int wv) { int t; asm volatile("v_mbcnt_lo_u32_b32 %0, -1, 0\n\tv_mbcnt_hi_u32_b32 %0, -1, %0\n\tv_lshl_add_u32 %0, %1, 6, %0" : "=&v"(t) : "s"(wv)); return t; }
namespace pg8 {
#define PG8_LAS __attribute__((address_space(3)))
typedef unsigned short bf16_t;
typedef short bf16x8 __attribute__((ext_vector_type(8)));
typedef float f32x4 __attribute__((ext_vector_type(4)));
typedef unsigned u32x4 __attribute__((ext_vector_type(4)));
typedef unsigned u32x2 __attribute__((ext_vector_type(2)));
constexpr int BM = 256, BK = 64, HALF = 128, HTB = HALF * BK * 2, STAGE_BYTES = 8 * HTB, NXCD = 8, WGM = 8;

__host__ __device__ __forceinline__ int lds_byte(int r, int c) { const int st = (r >> 4) * 2 + (c >> 5), rr = r & 15, cc = c & 31, ob = rr * 64 + cc * 2; return st * 1024 + (ob ^ (((ob >> 9) & 1) << 5)); }
__host__ __device__ __forceinline__ void stage_rc(int b, int& R, int& C) { const int st = b / 1024, sb = b % 1024, swz = sb ^ (((sb >> 9) & 1) << 5); R = (st >> 1) * 16 + swz / 64; C = (st & 1) * 32 + (swz % 64) / 2; }

struct Unit { int pm, pn; };
struct Gemm { const bf16_t* A; const bf16_t* Bt; int M, N, K; };

struct StaticOrder {
    int nM, nN, nwg, G, c;
    __host__ __device__ void init(int M, int N, int G_, int c_) { nM = M / BM; nN = N / BM; nwg = nM * nN; G = G_; c = c_; }
    __host__ __device__ bool next(int i, Unit& u) const {
        const long L = (long)i * G + c; if (L >= nwg) return false;
        int wgid = (int)L; { const int q = nwg / NXCD, r = nwg % NXCD, xcd = wgid % NXCD, off = wgid / NXCD; wgid = (xcd < r ? xcd * (q + 1) : r * (q + 1) + (xcd - r) * q) + off; }
        const int nig = WGM * nN, gid = wgid / nig, fm = gid * WGM, gsz = (nM - fm) < WGM ? (nM - fm) : WGM;
        u.pm = fm + ((wgid % nig) % gsz); u.pn = (wgid % nig) / gsz; return true;
    }
};

template <class Epi, class Sched>
__device__ __forceinline__ void gemm_phase(int wv, PG8_LAS unsigned char* lds, const Gemm g, const Sched& S, const Epi& E) {
    const int tid = opaque_tid(wv), wid = __builtin_amdgcn_readfirstlane(tid >> 6), lane = tid & 63, wr = wid >> 2, wc = wid & 3, fr = lane & 15, fq = lane >> 4;
    const int K = g.K, nt = K / BK;
    unsigned voffA[2], voffB[2];
#pragma unroll
    for (int i = 0; i < 2; ++i) { int R, C; stage_rc(tid * 16 + i * 8192, R, C); voffA[i] = (unsigned)(R * K + C) * 2u; voffB[i] = (unsigned)(R * K + C) * 2u; }
    const size_t kstep = (size_t)(BK * 2);
    const size_t hstep = (size_t)HALF * K * 2;
    const size_t tstep = 2 * hstep;
    const unsigned ldsw = (unsigned)wid * 1024u;
    const int aoff = lds_byte(wr * 64 + fr, fq * 8), boff = lds_byte(wc * 32 + fr, fq * 8);
#define PG8_SA(b, h) (((b) * 2 + (h)) * HTB)
#define PG8_SB(b, h) ((4 + (b) * 2 + (h)) * HTB)
#define PG8_STAGE(bufoff, gbase, voff) do { _Pragma("unroll") for (int _i = 0; _i < 2; ++_i) \
        __builtin_amdgcn_global_load_lds((const unsigned*)((const char*)(gbase) + (voff)[_i]), (PG8_LAS unsigned*)(lds + (bufoff) + ldsw + _i * 8192), 16, 0, 0); } while (0)
#define PG8_LDA(dst, b, h) do { _Pragma("unroll") for (int m = 0; m < 4; ++m) _Pragma("unroll") for (int k = 0; k < 2; ++k) dst[m][k] = *(const PG8_LAS bf16x8*)(lds + PG8_SA(b, h) + aoff + m * 2048 + k * 1024); } while (0)
#define PG8_LDB(dst, b, h) do { _Pragma("unroll") for (int n = 0; n < 2; ++n) _Pragma("unroll") for (int k = 0; k < 2; ++k) dst[n][k] = *(const PG8_LAS bf16x8*)(lds + PG8_SB(b, h) + boff + n * 2048 + k * 1024); } while (0)
#define PG8_MMA(ai, bj, At, Bt) do { __builtin_amdgcn_s_setprio(1); _Pragma("unroll") for (int m = 0; m < 4; ++m) _Pragma("unroll") for (int n = 0; n < 2; ++n) _Pragma("unroll") for (int k = 0; k < 2; ++k) \
        acc[ai][bj][m][n] = __builtin_amdgcn_mfma_f32_16x16x32_bf16(Bt[n][k], At[m][k], acc[ai][bj][m][n], 0, 0, 0); __builtin_amdgcn_s_setprio(0); } while (0)
#define PG8_WAIT_V(n) asm volatile("s_waitcnt vmcnt(" #n ")" ::: "memory")
#define PG8_WAIT_L(n) asm volatile("s_waitcnt lgkmcnt(" #n ")" ::: "memory")
#define PG8_BAR __builtin_amdgcn_s_barrier()
#define PG8_SCHED __builtin_amdgcn_sched_barrier(0)
    Unit cur, nxt; int ui = 0;
    if (!S.next(0, cur)) return;
    f32x4 acc[2][2][4][2];
#pragma unroll
    for (int a = 0; a < 2; ++a)
#pragma unroll
        for (int b = 0; b < 2; ++b)
#pragma unroll
            for (int m = 0; m < 4; ++m)
#pragma unroll
                for (int n = 0; n < 2; ++n) acc[a][b][m][n] = (f32x4){0.f, 0.f, 0.f, 0.f};
    bf16x8 At[4][2], B0[2][2], B1[2][2];
    const char* cA = (const char*)g.A + (size_t)cur.pm * tstep; const char* cB = (const char*)g.Bt + (size_t)cur.pn * tstep;
    PG8_STAGE(PG8_SB(0, 0), cB, voffB); PG8_STAGE(PG8_SA(0, 0), cA, voffA); PG8_STAGE(PG8_SB(0, 1), cB + hstep, voffB); PG8_STAGE(PG8_SA(0, 1), cA + hstep, voffA);
    if (wr == 1) PG8_BAR;
    PG8_WAIT_V(4); PG8_BAR;
    PG8_STAGE(PG8_SB(1, 0), cB + kstep, voffB); PG8_STAGE(PG8_SA(1, 0), cA + kstep, voffA); PG8_STAGE(PG8_SB(1, 1), cB + hstep + kstep, voffB);
    PG8_WAIT_V(6); PG8_BAR;
    for (;;) {
        const bool has_next = S.next(ui + 1, nxt);
        const char* nA = has_next ? (const char*)g.A + (size_t)nxt.pm * tstep : cA; const char* nB = has_next ? (const char*)g.Bt + (size_t)nxt.pn * tstep : cB;
        for (int t = 0; t < nt; t += 2) {
            const bool last = (t == nt - 2);
            const char* a1 = cA + (size_t)(t + 1) * kstep;
            const char* a2 = last ? nA : cA + (size_t)(t + 2) * kstep; const char* b2 = last ? nB : cB + (size_t)(t + 2) * kstep;
            const char* a3 = a2 + kstep; const char* b3 = b2 + kstep;
            PG8_LDB(B0, 0, 0); PG8_SCHED; PG8_LDA(At, 0, 0); PG8_STAGE(PG8_SA(1, 1), a1 + hstep, voffA);
            PG8_WAIT_L(8); PG8_BAR; PG8_WAIT_L(0); PG8_MMA(0, 0, At, B0); PG8_BAR; PG8_SCHED;
            PG8_LDB(B1, 0, 1); PG8_STAGE(PG8_SB(0, 0), b2, voffB);
            PG8_BAR; PG8_WAIT_L(0); PG8_MMA(0, 1, At, B1); PG8_BAR;
            PG8_LDA(At, 0, 1); PG8_STAGE(PG8_SA(0, 0), a2, voffA);
            PG8_BAR; PG8_WAIT_L(0); PG8_MMA(1, 0, At, B0); PG8_BAR; PG8_SCHED;
            PG8_STAGE(PG8_SB(0, 1), b2 + hstep, voffB);
            PG8_WAIT_V(6); PG8_BAR; PG8_MMA(1, 1, At, B1); PG8_BAR;
            PG8_LDB(B0, 1, 0); PG8_SCHED; PG8_LDA(At, 1, 0); PG8_STAGE(PG8_SA(0, 1), a2 + hstep, voffA);
            PG8_WAIT_L(8); PG8_BAR; PG8_WAIT_L(0); PG8_MMA(0, 0, At, B0); PG8_BAR; PG8_SCHED;
            PG8_LDB(B1, 1, 1); PG8_STAGE(PG8_SB(1, 0), b3, voffB);
            PG8_BAR; PG8_WAIT_L(0); PG8_MMA(0, 1, At, B1); PG8_BAR;
            PG8_LDA(At, 1, 1); PG8_STAGE(PG8_SA(1, 0), a3, voffA);
            PG8_BAR; PG8_WAIT_L(0); PG8_MMA(1, 0, At, B0); PG8_BAR; PG8_SCHED;
            PG8_STAGE(PG8_SB(1, 1), b3 + hstep, voffB);
            PG8_WAIT_V(6); PG8_BAR; PG8_MMA(1, 1, At, B1); PG8_BAR;
        }
        E(acc, cur, wr, wc, fr, fq);
        if (!has_next) break;
#pragma unroll
        for (int a = 0; a < 2; ++a)
#pragma unroll
            for (int b = 0; b < 2; ++b)
#pragma unroll
                for (int m = 0; m < 4; ++m)
#pragma unroll
                    for (int n = 0; n < 2; ++n) acc[a][b][m][n] = (f32x4){0.f, 0.f, 0.f, 0.f};
        cur = nxt; cA = nA; cB = nB; ++ui;
    }
    PG8_WAIT_V(0);
    if (wr == 0) PG8_BAR;
    PG8_BAR;
#undef PG8_SA
#undef PG8_SB
#undef PG8_STAGE
#undef PG8_LDA
#undef PG8_LDB
#undef PG8_MMA
#undef PG8_WAIT_V
#undef PG8_WAIT_L
#undef PG8_BAR
#undef PG8_SCHED
}
}

using pg8::bf16_t; using pg8::bf16x8; using pg8::f32x4; using pg8::u32x2; using pg8::u32x4; using pg8::Unit;

constexpr int MROWS = 17408, MP = 16384, DM = 1024, LDZ = 3328, DFF = 4096, NIN = 41;
constexpr float EPSF = 1e-6f;
constexpr int LDS_BYTES = 139264 + 256;
constexpr int LDS_XB = 139264;

constexpr size_t WS_BIG = 0;
constexpr size_t BIG_BYTES = (size_t)MROWS * DFF * 2;
constexpr size_t WS_WB = WS_BIG + BIG_BYTES;
constexpr size_t WO_IN_AB = 0;
constexpr size_t WO_OUT_AB = WO_IN_AB + (size_t)LDZ * 1024;
constexpr size_t WO_UP0 = WO_OUT_AB + (size_t)1024 * 1024;
constexpr size_t WO_DOWN0 = WO_UP0 + (size_t)4096 * 1024;
constexpr size_t WO_GATE0 = WO_DOWN0 + (size_t)4096 * 1024;
constexpr size_t WO_PROJ0 = WO_GATE0 + (size_t)1024 * 1024;
constexpr size_t WO_IN_CD = WO_PROJ0 + (size_t)1024 * 256;
constexpr size_t WO_GLU = WO_IN_CD + (size_t)1024 * 1024;
constexpr size_t WO_OUT_CD = WO_GLU + (size_t)512 * 512;
constexpr size_t WO_UP1 = WO_OUT_CD + (size_t)1024 * 1024;
constexpr size_t WO_DOWN1 = WO_UP1 + (size_t)4096 * 1024;
constexpr size_t WO_GATE1 = WO_DOWN1 + (size_t)4096 * 1024;
constexpr size_t WO_PROJ1 = WO_GATE1 + (size_t)1024 * 1024;
constexpr size_t WB_ELEMS = WO_PROJ1 + (size_t)1024 * 256;
constexpr size_t WS_X = WS_WB + WB_ELEMS * 2;
constexpr size_t ABUF_BYTES = (size_t)MROWS * DM * 2;
constexpr size_t WS_Y = WS_X + ABUF_BYTES;
constexpr size_t WS_SS = WS_Y + ABUF_BYTES;
constexpr size_t WS_BAR = WS_SS + (size_t)7 * MROWS * 4;
constexpr size_t WS_END = WS_BAR + 16384;
static_assert(WS_END <= (size_t)268435456, "workspace over 256 MiB");
constexpr size_t BIG_Z1 = 0;
constexpr size_t BIG_YG = (size_t)MROWS * DM * 4;
constexpr size_t BIG_META = (size_t)MROWS * LDZ * 2;

constexpr size_t O_Y = 0;
constexpr size_t O_CONV_P = (size_t)MROWS * DM;
constexpr size_t O_DELTA_P = O_CONV_P + 8 * 3 * 1536;
constexpr size_t O_SGUV_P = O_DELTA_P + (size_t)8 * 4 * 128 * 128;
constexpr size_t O_POOL_P = O_SGUV_P + (size_t)8 * 128 * 512;
constexpr size_t O_S5RE_P = O_POOL_P + (size_t)8 * 15 * 512;
constexpr size_t O_S5IM_P = O_S5RE_P + (size_t)8 * 32 * 64;
constexpr size_t O_CONV_S = O_S5IM_P + (size_t)8 * 32 * 64;
constexpr size_t O_DELTA_S = O_CONV_S + (size_t)128 * 3 * 1536;
constexpr size_t O_SGUV_S = O_DELTA_S + (size_t)128 * 4 * 128 * 128;
constexpr size_t O_POOL_S = O_SGUV_S + (size_t)128 * 8 * 512;
constexpr size_t O_S5RE_S = O_POOL_S + (size_t)128 * 15 * 512;
constexpr size_t O_S5IM_S = O_S5RE_S + (size_t)128 * 32 * 64;
constexpr size_t O_END = O_S5IM_S + (size_t)128 * 32 * 64;

enum { I_XP = 0, I_XS, I_SCONV, I_SDELTA, I_SPOOL, I_S5RE, I_S5IM, I_PP, I_PS, I_NMIX, I_NFFN, I_NPE, I_NFINAL, I_WINAB, I_CONVW, I_ALOG, I_DTB, I_NORMO, I_LNG, I_LNB,
       I_WSP, I_BSP, I_WOUTAB, I_WINCD, I_WPOOL, I_PSCALE, I_LAMRE, I_LAMIM, I_LOGDT, I_BRE, I_BIM, I_CRE, I_CIM, I_DSKIP, I_WGLU, I_BGLU, I_WOUTCD, I_WUP, I_WDOWN, I_WPROJ, I_WGATE };

struct Params { const float* in[NIN]; float* out; unsigned char* ws; };

__device__ __forceinline__ float bf2f(bf16_t v) { return __uint_as_float(((unsigned)v) << 16); }
__device__ __forceinline__ unsigned pk2(float lo, float hi) { unsigned r; asm volatile("v_cvt_pk_bf16_f32 %0, %1, %2" : "=v"(r) : "v"(lo), "v"(hi)); return r; }
__device__ __forceinline__ bf16_t f2bf(float f) { return (bf16_t)(pk2(f, 0.f) & 0xffffu); }
__device__ __forceinline__ float sigmoidf_(float x) { return 1.0f / (1.0f + __expf(-x)); }
__device__ __forceinline__ float siluf_(float x) { return x / (1.0f + __expf(-x)); }
__device__ __forceinline__ float geluf_(float x) { const float y = 1.5957691216f * (x + 0.044715f * x * x * x); return x / (1.0f + __expf(-y)); }
template <int CTRL> __device__ __forceinline__ float dpp_f(float x) { return __builtin_bit_cast(float, __builtin_amdgcn_mov_dpp(__builtin_bit_cast(int, x), CTRL, 0xf, 0xf, true)); }
__device__ __forceinline__ float row16_sum(float v) { v += dpp_f<0xB1>(v); v += dpp_f<0x4E>(v); v += dpp_f<0x141>(v); v += dpp_f<0x140>(v); return v; }
__device__ __forceinline__ float rdlane(float v, int l) { return __builtin_bit_cast(float, __builtin_amdgcn_readlane(__builtin_bit_cast(int, v), l)); }
__device__ __forceinline__ float wave_sum(float v) { v = row16_sum(v); return (rdlane(v, 0) + rdlane(v, 16)) + (rdlane(v, 32) + rdlane(v, 48)); }
__device__ __forceinline__ float shfl_xor_l(float v, int lane, int m) { return __builtin_bit_cast(float, __builtin_amdgcn_ds_bpermute((lane ^ m) << 2, __builtin_bit_cast(int, v))); }
__device__ __forceinline__ float rstd_of(const float* ss, int row) { return rsqrtf(ss[row] * (1.0f / 1024.0f) + EPSF); }

#define EPI_LOOP_ROWS for (int ai = 0; ai < 2; ++ai) for (int m = 0; m < 4; ++m)
#define EPI_LOOP_COLS for (int bj = 0; bj < 2; ++bj) for (int n = 0; n < 2; ++n)

struct EpiZ {
    bf16_t* Z; int ldz; const float* ss;
    __device__ __forceinline__ void operator()(const f32x4 (&acc)[2][2][4][2], const Unit& u, int wr, int wc, int fr, int fq) const {
        const int row0 = u.pm * 256 + wr * 64 + fr, col0 = u.pn * 256 + wc * 32 + 4 * fq;
#pragma unroll
        EPI_LOOP_ROWS { const int row = row0 + ai * 128 + m * 16; const float rs = rstd_of(ss, row); bf16_t* rp = Z + (size_t)row * ldz + col0;
#pragma unroll
            EPI_LOOP_COLS { const f32x4 v = acc[ai][bj][m][n] * rs; u32x2 w; w.x = pk2(v[0], v[1]); w.y = pk2(v[2], v[3]); *(u32x2*)(rp + bj * 128 + n * 16) = w; } }
    }
};
struct QZ1 {
    float* Z; const float* ss;
    __device__ __forceinline__ float operator()(int row, int col, const f32x4 a) const { *(f32x4*)(Z + (size_t)row * 1024 + col) = a * rstd_of(ss, row); return 0.f; }
};
struct QUp {
    bf16_t* Hd; const float* ss;
    __device__ __forceinline__ float operator()(int row, int col, const f32x4 a) const { f32x4 v = a * rstd_of(ss, row);
#pragma unroll
        for (int j = 0; j < 4; ++j) { const float r = fmaxf(v[j], 0.f); v[j] = r * r; }
        u32x2 w; w.x = pk2(v[0], v[1]); w.y = pk2(v[2], v[3]); *(u32x2*)(Hd + (size_t)row * DFF + col) = w; return 0.f; }
};
__device__ __forceinline__ f32x4 bf4_to_f(const u32x2 r) { f32x4 y; y[0] = __uint_as_float(r.x << 16); y[1] = __uint_as_float(r.x & 0xffff0000u); y[2] = __uint_as_float(r.y << 16); y[3] = __uint_as_float(r.y & 0xffff0000u); return y; }
struct QResF {
    const float* resP; const float* resS; bf16_t* HB;
    __device__ __forceinline__ float operator()(int row, int col, const f32x4 a) const {
        const float* rr = (row < MP ? resP + (size_t)row * 1024 : resS + (size_t)(row - MP) * 1024) + col; const f32x4 v = *(const f32x4*)rr + a;
        u32x2 w; w.x = pk2(v[0], v[1]); w.y = pk2(v[2], v[3]); *(u32x2*)(HB + (size_t)row * 1024 + col) = w;
        return (v[0] * v[0] + v[1] * v[1]) + (v[2] * v[2] + v[3] * v[3]); }
};
struct QResB {
    const bf16_t* R; bf16_t* HB;
    __device__ __forceinline__ float operator()(int row, int col, const f32x4 a) const {
        const f32x4 v = bf4_to_f(*(const u32x2*)(R + (size_t)row * 1024 + col)) + a;
        u32x2 w; w.x = pk2(v[0], v[1]); w.y = pk2(v[2], v[3]); *(u32x2*)(HB + (size_t)row * 1024 + col) = w;
        return (v[0] * v[0] + v[1] * v[1]) + (v[2] * v[2] + v[3] * v[3]); }
};
struct QGate {
    bf16_t* G; const float* ss;
    __device__ __forceinline__ float operator()(int row, int col, const f32x4 a) const { f32x4 v = a * rstd_of(ss, row);
#pragma unroll
        for (int j = 0; j < 4; ++j) v[j] = sigmoidf_(v[j]);
        u32x2 w; w.x = pk2(v[0], v[1]); w.y = pk2(v[2], v[3]); *(u32x2*)(G + (size_t)row * 1024 + col) = w; return 0.f; }
};
struct QProj {
    const bf16_t* G; const bf16_t* R; bf16_t* HB;
    __device__ __forceinline__ float operator()(int row, int col, const f32x4 a) const {
        const f32x4 v = bf4_to_f(*(const u32x2*)(R + (size_t)row * 1024 + col)) + a * bf4_to_f(*(const u32x2*)(G + (size_t)row * 1024 + col));
        u32x2 w; w.x = pk2(v[0], v[1]); w.y = pk2(v[2], v[3]); *(u32x2*)(HB + (size_t)row * 1024 + col) = w;
        return (v[0] * v[0] + v[1] * v[1]) + (v[2] * v[2] + v[3] * v[3]); }
};
template <class Q, bool HAS_SS> struct EpiQ {
    Q q; float* ssout;
    __device__ __forceinline__ void operator()(const f32x4 (&acc)[2][2][4][2], const Unit& u, int wr, int wc, int fr, int fq) const {
        const int row0 = u.pm * 256 + wr * 64 + fr, col0 = u.pn * 256 + wc * 32 + 4 * fq;
#pragma unroll
        EPI_LOOP_ROWS { const int row = row0 + ai * 128 + m * 16; float s = 0.f;
#pragma unroll
            EPI_LOOP_COLS { s += q(row, col0 + bj * 128 + n * 16, acc[ai][bj][m][n]); }
            if (HAS_SS) { s += shfl_xor_l(s, fq * 16 + fr, 16); s += shfl_xor_l(s, fq * 16 + fr, 32); if (fq == 0) atomicAdd(ssout + row, s); } }
    }
};
template <class Q, bool HAS_SS, int KSPLIT = 8>
__device__ __forceinline__ void tail_gemm(int wv, unsigned char* smem_b, const bf16_t* A  , int lda, const bf16_t* Bt, int N, int K, const Q& q, float* ssout) {
    constexpr int TP = 8 / KSPLIT;
    const int tid = opaque_tid(wv), lane = tid & 63, wid = __builtin_amdgcn_readfirstlane(tid >> 6), fr = lane & 15, fq = lane >> 4;
    const int ntn = N >> 6, ngroups = (16 * ntn) / TP, kw = K / KSPLIT, ts = wid / KSPLIT, k_lo = (wid % KSPLIT) * kw;
    f32x4* red = (f32x4*)smem_b;
    for (int g = blockIdx.x; g < ngroups; g += gridDim.x) {
        const int t = g * TP + ts, r0 = (t / ntn) * 64, c0 = (t % ntn) * 64;
        const bf16_t* ap = A + (size_t)(r0 + fr) * lda + k_lo + fq * 8; const bf16_t* bp = Bt + (size_t)(c0 + fr) * K + k_lo + fq * 8;
        f32x4 acc[4][4];
#pragma unroll
        for (int i = 0; i < 4; ++i)
#pragma unroll
            for (int j = 0; j < 4; ++j) acc[i][j] = (f32x4){0.f, 0.f, 0.f, 0.f};
#pragma unroll 2
        for (int k0 = 0; k0 < kw; k0 += 32) {
            bf16x8 af[4], bf[4];
#pragma unroll
            for (int i = 0; i < 4; ++i) { af[i] = *(const bf16x8*)(ap + (size_t)(i * 16) * lda + k0); bf[i] = *(const bf16x8*)(bp + (size_t)(i * 16) * K + k0); }
#pragma unroll
            for (int i = 0; i < 4; ++i)
#pragma unroll
                for (int j = 0; j < 4; ++j) acc[i][j] = __builtin_amdgcn_mfma_f32_16x16x32_bf16(bf[j], af[i], acc[i][j], 0, 0, 0);
        }
        __syncthreads();
#pragma unroll
        for (int i = 0; i < 4; ++i)
#pragma unroll
            for (int j = 0; j < 4; ++j) red[(wid * 16 + i * 4 + j) * 64 + lane] = acc[i][j];
        __syncthreads();
#pragma unroll
        for (int hq = 0; hq < 2 * TP; ++hq) {
            const int qd = tid + hq * 512, tsq = qd >> 10, ij = (qd >> 6) & 15, ln = qd & 63; f32x4 v = red[((tsq * KSPLIT) * 16 + ij) * 64 + ln];
#pragma unroll
            for (int w = 1; w < KSPLIT; ++w) v += red[((tsq * KSPLIT + w) * 16 + ij) * 64 + ln];
            const int tq = g * TP + tsq, r0q = (tq / ntn) * 64, c0q = (tq % ntn) * 64;
            const int row = MP + r0q + (ij >> 2) * 16 + (ln & 15), col = c0q + (ij & 3) * 16 + (ln >> 4) * 4;
            float sq = q(row, col, v);
            if (HAS_SS) { sq += shfl_xor_l(sq, lane, 16); sq += shfl_xor_l(sq, lane, 32); if (fq == 0) atomicAdd(ssout + row, sq); }
        }
    }
}
struct EpiGlu {
    const bf16_t* YG; const float* bg; bf16_t* Mix;
    __device__ __forceinline__ void operator()(const f32x4 (&acc)[2][2][4][2], const Unit& u, int wr, int wc, int fr, int fq) const {
        const int row0 = u.pm * 256 + wr * 64 + fr, col0 = u.pn * 256 + wc * 32 + 4 * fq;
#pragma unroll
        EPI_LOOP_ROWS { const int row = row0 + ai * 128 + m * 16;
#pragma unroll
            EPI_LOOP_COLS { const int col = col0 + bj * 128 + n * 16; const u32x2 yv = *(const u32x2*)(YG + (size_t)row * 512 + col); const f32x4 b = *(const f32x4*)(bg + col);
                const f32x4 a = acc[ai][bj][m][n] + b; f32x4 y; y[0] = __uint_as_float(yv.x << 16); y[1] = __uint_as_float(yv.x & 0xffff0000u); y[2] = __uint_as_float(yv.y << 16); y[3] = __uint_as_float(yv.y & 0xffff0000u);
                f32x4 v;
#pragma unroll
                for (int j = 0; j < 4; ++j) v[j] = y[j] * sigmoidf_(a[j]);
                u32x2 w; w.x = pk2(v[0], v[1]); w.y = pk2(v[2], v[3]); *(u32x2*)(Mix + (size_t)row * 1024 + 512 + col) = w; } }
    }
};

template <class Epi>
__device__ __forceinline__ void run_gemm(int wv, PG8_LAS unsigned char* lds, const bf16_t* A, const bf16_t* Bt, int M, int N, int K, const Epi& E) {
    pg8::StaticOrder S; S.init(M, N, (int)gridDim.x, (int)blockIdx.x);
    pg8::Gemm g{A, Bt, M, N, K};
    pg8::gemm_phase<Epi, pg8::StaticOrder>(wv, lds, g, S, E);
}

__device__ __forceinline__ void conv_outcd_fold(int wv, float* smem, const float* W, const float* wp, const float* sc, bf16_t* dst, int& tcount, int bid, int nb) {
    const int tid = opaque_tid(wv);
    float* tile = smem; float* As = smem + 64 * 65; float* Bs = As + 64 * 129;
    for (int t = (bid - tcount % nb + nb) % nb; t < 8 * 16; t += nb) {
        const int k0 = (t & 7) * 64, n0 = (t >> 3) * 64, gi = k0 >> 7, i0 = k0 & 127;
        __syncthreads();
#pragma unroll
        for (int i = 0; i < 16; ++i) { const int e = tid + i * 512, ii = e >> 7, j = e & 127; As[ii * 129 + j] = wp[((size_t)gi * 128 + i0 + ii) * 128 + j] * sc[gi * 128 + j]; }
#pragma unroll
        for (int i = 0; i < 16; ++i) { const int e = tid + i * 512, j = e >> 6, jn = e & 63; Bs[j * 65 + jn] = W[(size_t)(gi * 128 + j) * 1024 + n0 + jn]; }
        __syncthreads();
        {
            const int jn = tid & 63, ikb = tid >> 6; float acc[8];
#pragma unroll
            for (int i = 0; i < 8; ++i) acc[i] = 0.f;
            for (int j = 0; j < 128; ++j) { const float bv = Bs[j * 65 + jn];
#pragma unroll
                for (int i = 0; i < 8; ++i) acc[i] += As[(ikb + i * 8) * 129 + j] * bv; }
#pragma unroll
            for (int i = 0; i < 8; ++i) tile[(ikb + i * 8) * 65 + jn] = acc[i];
        }
        __syncthreads();
#pragma unroll
        for (int i = 0; i < 4; ++i) { const int e = tid + i * 512, jn = e >> 5, ik = (e & 31) * 2;
            *(unsigned*)(dst + (size_t)(n0 + jn) * 1024 + k0 + ik) = pk2(tile[ik * 65 + jn], tile[(ik + 1) * 65 + jn]); }
    }
    tcount += 8 * 16;
}

__device__ __forceinline__ void conv_weight(int wv, float* tile, const float* W, const float* g, bf16_t* dst, int K, int N, int Npad, int& tcount, int bid, int nb, int ldd = 0, int koff = 0) {
    if (ldd == 0) ldd = K;
    const int nkt = K / 64, nnt = Npad / 256, tot = nkt * nnt, tid = opaque_tid(wv), lane = tid & 63, wid = tid >> 6;
    for (int t = (bid - tcount % nb + nb) % nb; t < tot; t += nb) {
        const int k0 = (t % nkt) * 64, n0 = (t / nkt) * 256, n = n0 + lane * 4;
        f32x4 v[8];
#pragma unroll
        for (int i = 0; i < 8; ++i) { const int k = k0 + wid * 8 + i;
            if (n + 3 < N) v[i] = *(const f32x4*)(W + (size_t)k * N + n);
            else { v[i] = (f32x4){0.f, 0.f, 0.f, 0.f};
#pragma unroll
                for (int e = 0; e < 4; ++e) if (n + e < N) v[i][e] = W[(size_t)k * N + n + e]; }
            if (g) v[i] *= g[k]; }
        __syncthreads();
#pragma unroll
        for (int i = 0; i < 8; ++i) {
#pragma unroll
            for (int e = 0; e < 4; ++e) tile[(wid * 8 + i) * 257 + lane * 4 + e] = v[i][e]; }
        __syncthreads();
#pragma unroll
        for (int i = 0; i < 16; ++i) { const int e = tid + i * 512, jn = e >> 5, ik = (e & 31) * 2;
            *(unsigned*)(dst + (size_t)(n0 + jn) * ldd + koff + k0 + ik) = pk2(tile[ik * 257 + jn], tile[(ik + 1) * 257 + jn]); }
    }
    tcount += tot;
}

__device__ __forceinline__ void convert_rest(int wv, const Params& p, float* smem, int vb, int nvb) {
    bf16_t* WB = (bf16_t*)(p.ws + WS_WB);
    int tc = 0;
    conv_weight(wv, smem, p.in[I_WOUTAB], nullptr, WB + WO_OUT_AB, 1024, 1024, 1024, tc, vb, nvb);
    conv_weight(wv, smem, p.in[I_WUP], p.in[I_NFFN], WB + WO_UP0, 1024, 4096, 4096, tc, vb, nvb);
    conv_weight(wv, smem, p.in[I_WDOWN], nullptr, WB + WO_DOWN0, 4096, 1024, 1024, tc, vb, nvb);
    conv_weight(wv, smem, p.in[I_WGATE], p.in[I_NPE], WB + WO_GATE0, 1024, 1024, 1024, tc, vb, nvb);
    conv_weight(wv, smem, p.in[I_WPROJ], nullptr, WB + WO_PROJ0, 256, 1024, 1024, tc, vb, nvb);
    conv_weight(wv, smem, p.in[I_WINCD], p.in[I_NMIX] + 1024, WB + WO_IN_CD, 1024, 1024, 1024, tc, vb, nvb);
    conv_weight(wv, smem, p.in[I_WGLU], nullptr, WB + WO_GLU, 512, 512, 512, tc, vb, nvb);
    conv_outcd_fold(wv, smem, p.in[I_WOUTCD], p.in[I_WPOOL], p.in[I_PSCALE], WB + WO_OUT_CD, tc, vb, nvb);
    conv_weight(wv, smem, p.in[I_WOUTCD] + (size_t)512 * 1024, nullptr, WB + WO_OUT_CD, 512, 1024, 1024, tc, vb, nvb, 1024, 512);
    conv_weight(wv, smem, p.in[I_WUP] + (size_t)1024 * 4096, p.in[I_NFFN] + 1024, WB + WO_UP1, 1024, 4096, 4096, tc, vb, nvb);
    conv_weight(wv, smem, p.in[I_WDOWN] + (size_t)4096 * 1024, nullptr, WB + WO_DOWN1, 4096, 1024, 1024, tc, vb, nvb);
    conv_weight(wv, smem, p.in[I_WGATE] + (size_t)1024 * 1024, p.in[I_NPE] + 1024, WB + WO_GATE1, 1024, 1024, 1024, tc, vb, nvb);
    conv_weight(wv, smem, p.in[I_WPROJ] + (size_t)256 * 1024, nullptr, WB + WO_PROJ1, 256, 1024, 1024, tc, vb, nvb);
}
__device__ __forceinline__ void phase0(int wv, const Params& p, float* smem) {
    bf16_t* WB = (bf16_t*)(p.ws + WS_WB);
    int tc = 0;
    conv_weight(wv, smem, p.in[I_WINAB], p.in[I_NMIX], WB + WO_IN_AB, 1024, 3080, LDZ, tc, (int)blockIdx.x, (int)gridDim.x);
    const int tid0 = opaque_tid(wv), lane = tid0 & 63, gw = blockIdx.x * 8 + (tid0 >> 6), nw = gridDim.x * 8;
    bf16_t* X = (bf16_t*)(p.ws + WS_X); float* ss = (float*)(p.ws + WS_SS);
    for (int rowa = gw; rowa < MROWS; rowa += 4 * nw) {
        f32x4 v[4][4];
#pragma unroll
        for (int k = 0; k < 4; ++k) { const int row = rowa + k * nw < MROWS ? rowa + k * nw : rowa;
            const float* xr = row < MP ? p.in[I_XP] + (size_t)row * 1024 : p.in[I_XS] + (size_t)(row - MP) * 1024;
#pragma unroll
            for (int i = 0; i < 4; ++i) v[k][i] = *(const f32x4*)(xr + (i * 64 + lane) * 4); }
#pragma unroll
        for (int k = 0; k < 4; ++k) { const int row = rowa + k * nw; float sq = 0.f;
            if (row < MROWS) {
#pragma unroll
                for (int i = 0; i < 4; ++i) { const f32x4 x = v[k][i]; sq += (x[0] * x[0] + x[1] * x[1]) + (x[2] * x[2] + x[3] * x[3]);
                    u32x2 w; w.x = pk2(x[0], x[1]); w.y = pk2(x[2], x[3]); *(u32x2*)(X + (size_t)row * 1024 + (i * 64 + lane) * 4) = w; }
                sq = wave_sum(sq);
                if (lane == 0) ss[row] = sq; } }
    }
    for (int i = blockIdx.x * 512 + tid0; i < 6 * MROWS; i += gridDim.x * 512) ss[MROWS + i] = 0.f;
}

struct DRaw { u32x4 qk[4]; u32x4 v[4]; f32x4 m; };
constexpr int DBUF_F = 32 * 128 * 2 + 32 * 16 + 32 * 4 + 32 * 16;
constexpr int DBUF_O = 32 * 128 * 2 + 32 * 16 + 32 * 4;
__device__ __forceinline__ void bf8_to_f(const u32x4 r, float (&x)[8]) {
#pragma unroll
    for (int i = 0; i < 4; ++i) { x[2 * i] = __uint_as_float(r[i] << 16); x[2 * i + 1] = __uint_as_float(r[i] & 0xffff0000u); } }

__device__ __forceinline__ void phase2p(int wv, const Params& p, float* smem) {
    const int tid = opaque_tid(wv), lane = tid & 63, wid = __builtin_amdgcn_readfirstlane(tid >> 6), nb = gridDim.x, bid = blockIdx.x;
    const bf16_t* Z = (const bf16_t*)(p.ws + WS_BIG); bf16_t* QK = (bf16_t*)(p.ws + WS_Y); f32x4* META = (f32x4*)(p.ws + WS_BIG + BIG_META);
    const float* cw = p.in[I_CONVW];
    const int half = wid >> 2, pw = wid & 3, pt = tid & 255, cv = pt & 31, tg = pt >> 5; const bool isq = cv < 16;
    float* lw = smem + wid * 2048;
    const int tok8 = lane >> 3, pr = lane & 7;
    u32x4 rawN[7]; bf16_t zbN = 0, zaN = 0;
    auto fetch = [&](int u) {
        const int h = u & 3, rowc = (u >> 2) * 32, t0 = rowc & 2047, zc0 = isq ? h * 128 + cv * 8 : 512 + h * 128 + (cv - 16) * 8;
#pragma unroll
        for (int r = 0; r < 7; ++r) { const int dt_ = tg * 4 - 3 + r; rawN[r] = (t0 + dt_) >= 0 ? *(const u32x4*)(Z + (size_t)(rowc + dt_) * LDZ + zc0) : (u32x4){0u, 0u, 0u, 0u}; }
        const size_t mr = (size_t)(rowc + pw * 8 + tok8); zbN = Z[mr * LDZ + 2048 + h]; zaN = Z[mr * LDZ + 2052 + h]; };
    if (bid * 2 + half < 2048) fetch(bid * 2 + half);
    for (int u = bid * 2 + half; u < 2048; u += nb * 2) {
        const int h = u & 3, rowc = (u >> 2) * 32;
        const int zc0 = isq ? h * 128 + cv * 8 : 512 + h * 128 + (cv - 16) * 8;
        u32x4 raw[7];
#pragma unroll
        for (int r = 0; r < 7; ++r) raw[r] = rawN[r];
        const size_t mrow = (size_t)(rowc + pw * 8 + tok8);
        const bf16_t zbv = zbN, zav = zaN;
        if (u + nb * 2 < 2048) fetch(u + nb * 2);
        float w[4][8];
#pragma unroll
        for (int i = 0; i < 4; ++i) { const f32x4 a0 = *(const f32x4*)(cw + i * 1536 + zc0), a1 = *(const f32x4*)(cw + i * 1536 + zc0 + 4);
#pragma unroll
            for (int e = 0; e < 4; ++e) { w[i][e] = a0[e]; w[i][4 + e] = a1[e]; } }
        float x[7][8];
#pragma unroll
        for (int r = 0; r < 7; ++r) bf8_to_f(raw[r], x[r]);
#pragma unroll
        for (int j = 0; j < 4; ++j) { float y[8]; float sq = 0.f;
#pragma unroll
            for (int e = 0; e < 8; ++e) { const float a = w[0][e] * x[j][e] + w[1][e] * x[j + 1][e] + w[2][e] * x[j + 2][e] + w[3][e] * x[j + 3][e]; y[e] = siluf_(a); sq += y[e] * y[e]; }
            sq = row16_sum(sq);
            const float sc = rsqrtf(sq + EPSF) * (isq ? 0.08838834764831845f : 1.0f);
            u32x4 o; o[0] = pk2(y[0] * sc, y[1] * sc); o[1] = pk2(y[2] * sc, y[3] * sc); o[2] = pk2(y[4] * sc, y[5] * sc); o[3] = pk2(y[6] * sc, y[7] * sc);
            *(u32x4*)(QK + (size_t)(rowc + tg * 4 + j) * 1024 + zc0) = o;
            float* d = lw + ((tg & 1) * 4 + j) * 256 + (isq ? 0 : 128) + (cv & 15) * 8;
            float yr[8]; bf8_to_f(o, yr);
            *(f32x4*)d = (f32x4){yr[0], yr[1], yr[2], yr[3]}; *(f32x4*)(d + 4) = (f32x4){yr[4], yr[5], yr[6], yr[7]}; }
        asm volatile("s_waitcnt lgkmcnt(0)" ::: "memory");
        {   const float* qp = lw + tok8 * 256 + pr * 16; const float* kp = qp + 128; float sdot = 0.f;
#pragma unroll
            for (int i = 0; i < 4; ++i) { const f32x4 a = *(const f32x4*)(qp + i * 4), c = *(const f32x4*)(kp + i * 4); sdot += (a[0] * c[0] + a[1] * c[1]) + (a[2] * c[2] + a[3] * c[3]); }
            sdot += dpp_f<0xB1>(sdot); sdot += dpp_f<0x4E>(sdot); sdot += dpp_f<0x141>(sdot);
            const float* ap2 = (tok8 & 1) ? (lw + (tok8 - 1) * 256 + 128 + pr * 16) : kp; const float* bp2 = (tok8 & 1) ? qp : (lw + (tok8 + 1) * 256 + 128 + pr * 16); float sd2 = 0.f;
#pragma unroll
            for (int i = 0; i < 4; ++i) { const f32x4 a = *(const f32x4*)(ap2 + i * 4), c = *(const f32x4*)(bp2 + i * 4); sd2 += (a[0] * c[0] + a[1] * c[1]) + (a[2] * c[2] + a[3] * c[3]); }
            sd2 += dpp_f<0xB1>(sd2); sd2 += dpp_f<0x4E>(sd2); sd2 += dpp_f<0x141>(sd2);
            if (pr == 0) { const float za = bf2f(zav) + p.in[I_DTB][h]; const float sp = za > 20.f ? za : log1pf(__expf(za));
                META[mrow * 4 + h] = (f32x4){__expf(-__expf(p.in[I_ALOG][h]) * sp), sigmoidf_(bf2f(zbv)), sdot, sd2}; } }
        asm volatile("s_waitcnt lgkmcnt(0)" ::: "memory");
    }
}

__device__ __forceinline__ void delta_prompt_item(int wv, const Params& p, float* smem, int b, int h, int col0) {
    const int tid = opaque_tid(wv), lane = tid & 63, wid = __builtin_amdgcn_readfirstlane(tid >> 6);
    const int row0 = b * 2048;
    const bf16_t* Z = (const bf16_t*)(p.ws + WS_BIG);
    float* ORAW = (float*)(p.ws + WS_X);
    const float* cw = p.in[I_CONVW];
    constexpr int NCH = 64;
    __syncthreads();
    if (wid >= 4) {
        const int pt = tid - 256, cv = pt & 31, tg = pt >> 5;
        const bool isq = cv < 16;
        const int zc0 = isq ? h * 128 + cv * 8 : 512 + h * 128 + (cv - 16) * 8;
        const int cvv = pt & 1, tokv = (pt >> 1) & 31, zcv = 1024 + h * 128 + col0 + cvv * 8;
        float wvv[4][8];
#pragma unroll
        for (int i = 0; i < 4; ++i) {
            const f32x4 b0 = *(const f32x4*)(cw + i * 1536 + zcv), b1 = *(const f32x4*)(cw + i * 1536 + zcv + 4);
#pragma unroll
            for (int e = 0; e < 4; ++e) { wvv[i][e] = b0[e]; wvv[i][4 + e] = b1[e]; }
        }
        const bf16_t* QK = (const bf16_t*)(p.ws + WS_Y); const f32x4* META = (const f32x4*)(p.ws + WS_BIG + BIG_META);
        auto issue = [&](int ch, DRaw& R) {
            const int t0 = ch * 32;
#pragma unroll
            for (int j = 0; j < 4; ++j) R.qk[j] = *(const u32x4*)(QK + (size_t)(row0 + t0 + tg * 4 + j) * 1024 + zc0);
            if (pt < 64) {
#pragma unroll
                for (int i = 0; i < 4; ++i) { const int tp = t0 + tokv - 3 + i; R.v[i] = tp >= 0 ? *(const u32x4*)(Z + (size_t)(row0 + tp) * LDZ + zcv) : (u32x4){0u, 0u, 0u, 0u}; }
            } else if (pt < 96) R.m = META[(size_t)(row0 + t0 + pt - 64) * 4 + h];
        };
        auto process = [&](const DRaw& R, float* buf) {
            float* qs = buf; float* ks = buf + 32 * 128; float* vs = buf + 2 * 32 * 128; float* meta = vs + 32 * 16;
            float* dst = (isq ? qs : ks) + (cv & 15) * 8;
#pragma unroll
            for (int j = 0; j < 4; ++j) { float y[8]; bf8_to_f(R.qk[j], y);
                *(f32x4*)(dst + (tg * 4 + j) * 128) = (f32x4){y[0], y[1], y[2], y[3]}; *(f32x4*)(dst + (tg * 4 + j) * 128 + 4) = (f32x4){y[4], y[5], y[6], y[7]}; }
            if (pt < 64) { float xv[4][8];
#pragma unroll
                for (int i = 0; i < 4; ++i) bf8_to_f(R.v[i], xv[i]);
                float y[8];
#pragma unroll
                for (int e = 0; e < 8; ++e) y[e] = siluf_(wvv[0][e] * xv[0][e] + wvv[1][e] * xv[1][e] + wvv[2][e] * xv[2][e] + wvv[3][e] * xv[3][e]);
                *(f32x4*)(vs + tokv * 16 + cvv * 8) = (f32x4){y[0], y[1], y[2], y[3]}; *(f32x4*)(vs + tokv * 16 + cvv * 8 + 4) = (f32x4){y[4], y[5], y[6], y[7]};
            } else if (pt < 96) *(f32x4*)(meta + (pt - 64) * 4) = R.m;
        };
        auto flush = [&](int ch) { const int tok = pt >> 3, c2 = (pt & 7) * 2; const float* ob = smem + (ch & 1) * DBUF_F + DBUF_O + tok * 16 + c2;
            typedef float f32x2_ __attribute__((ext_vector_type(2)));
            *(f32x2_*)(ORAW + (size_t)(row0 + ch * 32 + tok) * 512 + h * 128 + col0 + c2) = *(const f32x2_*)ob; };
        DRaw R0, R1, R2, R3;
        issue(0, R0); issue(1, R1); issue(2, R2); issue(3, R3);
        process(R0, smem); issue(4, R0);
        __syncthreads();
        for (int j = 0; j < NCH; j += 4) {
            if (j + 1 < NCH) process(R1, smem + DBUF_F);
            if (j + 5 < NCH) issue(j + 5, R1);
            if (j > 0) flush(j - 1);
            __syncthreads();
            if (j + 2 < NCH) process(R2, smem);
            if (j + 6 < NCH) issue(j + 6, R2);
            flush(j);
            __syncthreads();
            if (j + 3 < NCH) process(R3, smem + DBUF_F);
            if (j + 7 < NCH) issue(j + 7, R3);
            flush(j + 1);
            __syncthreads();
            if (j + 4 < NCH) process(R0, smem);
            if (j + 8 < NCH) issue(j + 8, R0);
            flush(j + 2);
            __syncthreads();
        }
        flush(NCH - 1);
    } else {
        const int part = lane & 15, cl = lane >> 4, col = col0 + wid * 4 + cl;
        typedef float f32x2 __attribute__((ext_vector_type(2)));
        f32x2 S2[4];
#pragma unroll
        for (int i = 0; i < 4; ++i) S2[i] = (f32x2){0.f, 0.f};
        __syncthreads();
        for (int i = 0; i < NCH; ++i) {
            float* ob = smem + (i & 1) * DBUF_F + DBUF_O + wid * 4 + cl;
            const float* buf = smem + (i & 1) * DBUF_F; const float* qs = buf; const float* ks = buf + 32 * 128; const float* vs = buf + 2 * 32 * 128; const float* meta = vs + 32 * 16;
            struct Tok { f32x4 ka, kb, qa, qb, mt; float v; };
            auto ldtok = [&](int tt) { Tok T; T.ka = *(const f32x4*)(ks + tt * 128 + part * 4); T.kb = *(const f32x4*)(ks + tt * 128 + 64 + part * 4);
                T.qa = *(const f32x4*)(qs + tt * 128 + part * 4); T.qb = *(const f32x4*)(qs + tt * 128 + 64 + part * 4); T.mt = *(const f32x4*)(meta + tt * 4); T.v = vs[tt * 16 + wid * 4 + cl]; return T; };
            Tok t1 = ldtok(0), t2 = ldtok(1);
#pragma unroll 4
            for (int tt = 0; tt < 32; tt += 2) {
                const int tn = tt < 30 ? tt + 2 : 30;
                const Tok n1 = ldtok(tn), n2 = ldtok(tn + 1);
#define SPLIT4(v4, lo, hi) const f32x2 lo = __builtin_shufflevector(v4, v4, 0, 1), hi = __builtin_shufflevector(v4, v4, 2, 3)
                SPLIT4(t1.ka, k10, k11); SPLIT4(t1.kb, k12, k13); SPLIT4(t1.qa, q10, q11); SPLIT4(t1.qb, q12, q13);
                SPLIT4(t2.ka, k20, k21); SPLIT4(t2.kb, k22, k23); SPLIT4(t2.qa, q20, q21); SPLIT4(t2.qb, q22, q23);
#undef SPLIT4
                f32x2 p1 = S2[0] * k10; p1 = S2[1] * k11 + p1; p1 = S2[2] * k12 + p1; p1 = S2[3] * k13 + p1;
                f32x2 p2 = S2[0] * k20; p2 = S2[1] * k21 + p2; p2 = S2[2] * k22 + p2; p2 = S2[3] * k23 + p2;
                f32x2 p3 = S2[0] * q10; p3 = S2[1] * q11 + p3; p3 = S2[2] * q12 + p3; p3 = S2[3] * q13 + p3;
                f32x2 p4 = S2[0] * q20; p4 = S2[1] * q21 + p4; p4 = S2[2] * q22 + p4; p4 = S2[3] * q23 + p4;
                float dk1 = p1.x + p1.y, dk2 = p2.x + p2.y, dq1 = p3.x + p3.y, dq2 = p4.x + p4.y;
                dk1 += dpp_f<0xB1>(dk1); dk2 += dpp_f<0xB1>(dk2); dq1 += dpp_f<0xB1>(dq1); dq2 += dpp_f<0xB1>(dq2);
                dk1 += dpp_f<0x4E>(dk1); dk2 += dpp_f<0x4E>(dk2); dq1 += dpp_f<0x4E>(dq1); dq2 += dpp_f<0x4E>(dq2);
                dk1 += dpp_f<0x141>(dk1); dk2 += dpp_f<0x141>(dk2); dq1 += dpp_f<0x141>(dq1); dq2 += dpp_f<0x141>(dq2);
                dk1 += dpp_f<0x140>(dk1); dk2 += dpp_f<0x140>(dk2); dq1 += dpp_f<0x140>(dq1); dq2 += dpp_f<0x140>(dq2);
                const float a1 = t1.mt[0], a2 = t2.mt[0];
                const float u1 = t1.mt[1] * (t1.v - a1 * dk1);
                const float s1k2 = a1 * dk2 + t1.mt[3] * u1;
                const float u2 = t2.mt[1] * (t2.v - a2 * s1k2);
                const float o1 = a1 * dq1 + t1.mt[2] * u1;
                const float o2 = a2 * (a1 * dq2 + t2.mt[3] * u1) + t2.mt[2] * u2;
                const float a12 = a1 * a2, c1 = a2 * u1;
                const f32x2 A2 = (f32x2){a12, a12}, C1 = (f32x2){c1, c1}, U2 = (f32x2){u2, u2};
                S2[0] = S2[0] * A2 + k10 * C1 + k20 * U2; S2[1] = S2[1] * A2 + k11 * C1 + k21 * U2; S2[2] = S2[2] * A2 + k12 * C1 + k22 * U2; S2[3] = S2[3] * A2 + k13 * C1 + k23 * U2;
                ob[tt * 16] = o1; ob[(tt + 1) * 16] = o2;
                t1 = n1; t2 = n2;
            }
            __syncthreads();
        }
        float* sp = p.out + O_DELTA_P + ((size_t)(b * 4 + h) * 128) * 128 + col;
#pragma unroll
        for (int i = 0; i < 4; ++i) { const int d = (i >> 1) * 64 + part * 4 + (i & 1) * 2; sp[(size_t)d * 128] = S2[i].x; sp[(size_t)(d + 1) * 128] = S2[i].y; }
    }
}

__device__ __forceinline__ void delta_sample_item(int wv, const Params& p, float* smem, int b, int h) {
    const int tid = opaque_tid(wv), lane = tid & 63, wid = __builtin_amdgcn_readfirstlane(tid >> 6);
    const int row0 = MP + b * 8;
    const bf16_t* Z = (const bf16_t*)(p.ws + WS_BIG);
    float* ORAW = (float*)(p.ws + WS_X);
    const float* cw = p.in[I_CONVW]; const float* sconv = p.in[I_SCONV] + (size_t)b * 3 * 1536;
    float* Ssh = smem; float* qs = smem + 128 * 128; float* ks = qs + 8 * 128; float* vs = ks + 8 * 128; float* meta = vs + 8 * 128;
    const float* sin_ = p.in[I_SDELTA] + (size_t)(b * 4 + h) * 128 * 128;
    __syncthreads();
    f32x4 st[8];
#pragma unroll
    for (int i = 0; i < 8; ++i) st[i] = *(const f32x4*)(sin_ + (size_t)(i * 512 + tid) * 4);
    if (tid < 384) {
        const int tt = tid / 48, cvx = tid - tt * 48; int zc; float* dst;
        if (cvx < 16) { zc = h * 128 + cvx * 8; dst = qs + tt * 128 + cvx * 8; } else if (cvx < 32) { zc = 512 + h * 128 + (cvx - 16) * 8; dst = ks + tt * 128 + (cvx - 16) * 8; } else { zc = 1024 + h * 128 + (cvx - 32) * 8; dst = vs + tt * 128 + (cvx - 32) * 8; }
        float acc[8];
#pragma unroll
        for (int e = 0; e < 8; ++e) acc[e] = 0.f;
#pragma unroll
        for (int i = 0; i < 4; ++i) { const int tp = tt - 3 + i; float x[8];
            if (tp >= 0) { const u32x4 r = *(const u32x4*)(Z + (size_t)(row0 + tp) * LDZ + zc); bf8_to_f(r, x); }
            else { const f32x4 a = *(const f32x4*)(sconv + (tp + 3) * 1536 + zc), c = *(const f32x4*)(sconv + (tp + 3) * 1536 + zc + 4);
#pragma unroll
                for (int e = 0; e < 4; ++e) { x[e] = a[e]; x[4 + e] = c[e]; } }
            const f32x4 w0 = *(const f32x4*)(cw + i * 1536 + zc), w1 = *(const f32x4*)(cw + i * 1536 + zc + 4);
#pragma unroll
            for (int e = 0; e < 4; ++e) { acc[e] += w0[e] * x[e]; acc[4 + e] += w1[e] * x[4 + e]; } }
        *(f32x4*)dst = (f32x4){siluf_(acc[0]), siluf_(acc[1]), siluf_(acc[2]), siluf_(acc[3])}; *(f32x4*)(dst + 4) = (f32x4){siluf_(acc[4]), siluf_(acc[5]), siluf_(acc[6]), siluf_(acc[7])};
    } else if (tid < 392) { const int tt = tid - 384; const size_t r = (size_t)(row0 + tt) * LDZ; const float zb = bf2f(Z[r + 2048 + h]), za = bf2f(Z[r + 2052 + h]) + p.in[I_DTB][h];
        const float sp = za > 20.f ? za : log1pf(__expf(za)); meta[tt * 4] = __expf(-__expf(p.in[I_ALOG][h]) * sp); meta[tt * 4 + 1] = sigmoidf_(zb); }
#pragma unroll
    for (int i = 0; i < 8; ++i) *(f32x4*)(Ssh + (size_t)(i * 512 + tid) * 4) = st[i];
    __syncthreads();
    {
        const int tt = wid; const float q0 = qs[tt * 128 + lane], q1 = qs[tt * 128 + 64 + lane], k0 = ks[tt * 128 + lane], k1 = ks[tt * 128 + 64 + lane];
        const float sq = rsqrtf(wave_sum(q0 * q0 + q1 * q1) + EPSF) * 0.08838834764831845f, sk = rsqrtf(wave_sum(k0 * k0 + k1 * k1) + EPSF);
        const float kq = wave_sum(q0 * k0 + q1 * k1) * sq * sk;
        qs[tt * 128 + lane] = q0 * sq; qs[tt * 128 + 64 + lane] = q1 * sq; ks[tt * 128 + lane] = k0 * sk; ks[tt * 128 + 64 + lane] = k1 * sk;
        if (lane == 0) meta[tt * 4 + 2] = kq;
    }
    __syncthreads();
    const int part = lane & 15, cl = lane >> 4;
    for (int pp = 0; pp < 4; ++pp) {
        const int col = pp * 32 + wid * 4 + cl; float S[8];
#pragma unroll
        for (int i = 0; i < 8; ++i) { const int d = (i >> 2) * 64 + part * 4 + (i & 3); S[i] = Ssh[d * 128 + col]; }
#pragma unroll
        for (int tt = 0; tt < 8; ++tt) {
            const f32x4 ka = *(const f32x4*)(ks + tt * 128 + part * 4), kb = *(const f32x4*)(ks + tt * 128 + 64 + part * 4);
            const f32x4 qa = *(const f32x4*)(qs + tt * 128 + part * 4), qb = *(const f32x4*)(qs + tt * 128 + 64 + part * 4);
            const f32x4 mt = *(const f32x4*)(meta + tt * 4); const float v = vs[tt * 128 + col];
            float d1 = ((S[0] * ka[0] + S[1] * ka[1]) + (S[2] * ka[2] + S[3] * ka[3])) + ((S[4] * kb[0] + S[5] * kb[1]) + (S[6] * kb[2] + S[7] * kb[3]));
            float d2 = ((S[0] * qa[0] + S[1] * qa[1]) + (S[2] * qa[2] + S[3] * qa[3])) + ((S[4] * qb[0] + S[5] * qb[1]) + (S[6] * qb[2] + S[7] * qb[3]));
            d1 = row16_sum(d1); d2 = row16_sum(d2);
            const float a = mt[0], uu = mt[1] * (v - a * d1);
#pragma unroll
            for (int e = 0; e < 4; ++e) { S[e] = a * S[e] + ka[e] * uu; S[4 + e] = a * S[4 + e] + kb[e] * uu; }
            if (part == 0) ORAW[(size_t)(row0 + tt) * 512 + h * 128 + col] = a * d2 + uu * mt[2];
        }
#pragma unroll
        for (int i = 0; i < 8; ++i) { const int d = (i >> 2) * 64 + part * 4 + (i & 3); Ssh[d * 128 + col] = S[i]; }
    }
    __syncthreads();
    float* sout = p.out + O_DELTA_S + (size_t)(b * 4 + h) * 128 * 128;
#pragma unroll
    for (int i = 0; i < 8; ++i) *(f32x4*)(sout + (size_t)(i * 512 + tid) * 4) = *(const f32x4*)(Ssh + (size_t)(i * 512 + tid) * 4);
}

__device__ __forceinline__ void phase2a(int wv, const Params& p, float* smem) {
    const int nb = gridDim.x, bid = blockIdx.x;
    for (int it = bid; it < 256; it += nb) { const int bh = it >> 3, sl = it & 7; delta_prompt_item(wv, p, smem, bh >> 2, bh & 3, sl * 16); }
    for (int it = bid; it < 512; it += nb) delta_sample_item(wv, p, smem, it >> 2, it & 3);
}


__device__ __forceinline__ void sgu_prompt_item(int wv, const Params& p, float* smem, int b, int nch, int g0) {
    const int tid = opaque_tid(wv), lane = tid & 63, wid = tid >> 6;
    const bf16_t* Z = (const bf16_t*)(p.ws + WS_BIG); bf16_t* Mix = (bf16_t*)(p.ws + WS_Y);
    bf16_t* vT = (bf16_t*)smem; float* st = smem + 16384;
    const int row0 = b * 2048 + nch * 128;
    const int fr = lane & 15, fq = lane >> 4, nks = (wid >> 1) + 1;
    __syncthreads();
    {
#pragma unroll
        for (int hb = 0; hb < 2; ++hb) {
            u32x4 raw[8];
#pragma unroll
            for (int k = 0; k < 8; ++k) raw[k] = *(const u32x4*)(Z + (size_t)(row0 + wid * 16 + hb * 8 + k) * LDZ + 2568 + lane * 8);
#pragma unroll
            for (int k = 0; k < 8; ++k) { float x[8];
#pragma unroll
                for (int i = 0; i < 4; ++i) { x[2 * i] = geluf_(__uint_as_float(raw[k][i] << 16)); x[2 * i + 1] = geluf_(__uint_as_float(raw[k][i] & 0xffff0000u)); }
                float sm = 0.f;
#pragma unroll
                for (int i = 0; i < 8; ++i) sm += x[i];
                const float mean = wave_sum(sm) * (1.0f / 512.0f); float q = 0.f;
#pragma unroll
                for (int i = 0; i < 8; ++i) { const float d = x[i] - mean; q += d * d; }
                const float var = wave_sum(q) * (1.0f / 512.0f);
                if (lane == 0) { const int t = wid * 16 + hb * 8 + k; st[t * 2] = mean; st[t * 2 + 1] = rsqrtf(var + EPSF); } }
        }
    }
    __syncthreads();
    for (int g = g0; g < g0 + 2; ++g) {
    bf16x8 wf[4];
    {   const float* wrow = p.in[I_WSP] + ((size_t)g * 128 + wid * 16 + fr) * 128; const int t = wid * 16 + fr;
#pragma unroll
        for (int ks = 0; ks < 4; ++ks) { unsigned w4[4] = {0u, 0u, 0u, 0u};
            if (ks < nks) { const int s0 = ks * 32 + fq * 8; const f32x4 a = *(const f32x4*)(wrow + s0), c4 = *(const f32x4*)(wrow + s0 + 4); float x[8] = {a[0], a[1], a[2], a[3], c4[0], c4[1], c4[2], c4[3]};
#pragma unroll
                for (int e = 0; e < 8; ++e) if (s0 + e > t) x[e] = 0.f;
#pragma unroll
                for (int e = 0; e < 4; ++e) w4[e] = pk2(x[2 * e], x[2 * e + 1]); }
            wf[ks] = __builtin_bit_cast(bf16x8, (u32x4){w4[0], w4[1], w4[2], w4[3]}); }
    }
    {
        const int cv = tid & 15; float lg8[8], lb8[8];
#pragma unroll
        for (int e = 0; e < 8; ++e) { lg8[e] = p.in[I_LNG][g * 128 + cv * 8 + e]; lb8[e] = p.in[I_LNB][g * 128 + cv * 8 + e]; }
        u32x4 raw[4];
#pragma unroll
        for (int j = 0; j < 4; ++j) { const int sI = (tid + j * 512) >> 4; raw[j] = *(const u32x4*)(Z + (size_t)(row0 + sI) * LDZ + 2568 + g * 128 + cv * 8); }
#pragma unroll
        for (int j = 0; j < 4; ++j) { const int sI = (tid + j * 512) >> 4; const float mean = st[sI * 2], rs = st[sI * 2 + 1]; float v[8];
#pragma unroll
            for (int i = 0; i < 4; ++i) { v[2 * i] = geluf_(__uint_as_float(raw[j][i] << 16)); v[2 * i + 1] = geluf_(__uint_as_float(raw[j][i] & 0xffff0000u)); }
#pragma unroll
            for (int e = 0; e < 8; ++e) v[e] = (v[e] - mean) * rs * lg8[e] + lb8[e];
#pragma unroll
            for (int e = 0; e < 8; ++e) vT[(cv * 8 + e) * 136 + sI] = f2bf(v[e]);
            if (nch == 15) { float* ov = p.out + O_SGUV_P + ((size_t)b * 128 + sI) * 512 + g * 128 + cv * 8; *(f32x4*)ov = (f32x4){v[0], v[1], v[2], v[3]}; *(f32x4*)(ov + 4) = (f32x4){v[4], v[5], v[6], v[7]}; } }
    }
    __syncthreads();
    {
        const int t = wid * 16 + fr; const float bs = p.in[I_BSP][g * 128 + t];
        u32x2 ur[8];
#pragma unroll
        for (int ct = 0; ct < 8; ++ct) ur[ct] = *(const u32x2*)(Z + (size_t)(row0 + t) * LDZ + 2056 + g * 128 + ct * 16 + fq * 4);
#pragma unroll
        for (int ct = 0; ct < 8; ++ct) { f32x4 acc = {0.f, 0.f, 0.f, 0.f};
#pragma unroll
            for (int ks = 0; ks < 4; ++ks) if (ks < nks) { const bf16x8 vf = *(const bf16x8*)(vT + (ct * 16 + fr) * 136 + ks * 32 + fq * 8); acc = __builtin_amdgcn_mfma_f32_16x16x32_bf16(vf, wf[ks], acc, 0, 0, 0); }
            const f32x4 u = bf4_to_f(ur[ct]); f32x4 o;
#pragma unroll
            for (int e = 0; e < 4; ++e) o[e] = geluf_(u[e]) * (acc[e] + bs);
            u32x2 w; w.x = pk2(o[0], o[1]); w.y = pk2(o[2], o[3]); *(u32x2*)(Mix + (size_t)(row0 + t) * 1024 + 512 + g * 128 + ct * 16 + fq * 4) = w; }
    }
    __syncthreads();
    }
}

__device__ __forceinline__ void sgu_sample_item(int wv, const Params& p, float* smem, int b) {
    const int tid = opaque_tid(wv), lane = tid & 63, wid = tid >> 6;
    const bf16_t* Z = (const bf16_t*)(p.ws + WS_BIG); bf16_t* Mix = (bf16_t*)(p.ws + WS_Y);
    float* vS = smem;
    const int row0 = MP + b * 8;
    __syncthreads();
    {   const int t = wid; const u32x4 raw = *(const u32x4*)(Z + (size_t)(row0 + t) * LDZ + 2568 + lane * 8); float x[8];
#pragma unroll
        for (int i = 0; i < 4; ++i) { x[2 * i] = geluf_(__uint_as_float(raw[i] << 16)); x[2 * i + 1] = geluf_(__uint_as_float(raw[i] & 0xffff0000u)); }
        float s = 0.f;
#pragma unroll
        for (int i = 0; i < 8; ++i) s += x[i];
        const float mean = wave_sum(s) * (1.0f / 512.0f); float q = 0.f;
#pragma unroll
        for (int i = 0; i < 8; ++i) { const float d = x[i] - mean; q += d * d; }
        const float rs = rsqrtf(wave_sum(q) * (1.0f / 512.0f) + EPSF);
#pragma unroll
        for (int i = 0; i < 8; ++i) { const int ch = lane * 8 + i; const float v = (x[i] - mean) * rs * p.in[I_LNG][ch] + p.in[I_LNB][ch]; vS[t * 512 + ch] = v; p.out[O_SGUV_S + ((size_t)b * 8 + t) * 512 + ch] = v; }
    }
    __syncthreads();
    const int ch = tid, g = ch >> 7; const float* wsp = p.in[I_WSP] + (size_t)g * 128 * 128; const float* bsp = p.in[I_BSP] + g * 128;
    bf16_t uraw[8];
#pragma unroll
    for (int t = 0; t < 8; ++t) uraw[t] = Z[(size_t)(row0 + t) * LDZ + 2056 + ch];
#pragma unroll
    for (int t = 0; t < 8; ++t) { float a = bsp[t];
#pragma unroll
        for (int s = 0; s <= t; ++s) a += wsp[t * 128 + s] * vS[s * 512 + ch];
        const float u = geluf_(bf2f(uraw[t]));
        Mix[(size_t)(row0 + t) * 1024 + 512 + ch] = f2bf(u * a); }
}

__device__ __forceinline__ void convert_p(int wv, const Params& p, int layer, bf16_t* dst, int vb, int nvb) {
    const float* pp = p.in[I_PP] + (size_t)layer * MP * 256; const float* ps = p.in[I_PS] + (size_t)layer * 1024 * 256;
    const size_t str_ = (size_t)nvb * 512, tot_ = (size_t)MROWS * 64;
    for (size_t i0 = (size_t)vb * 512 + opaque_tid(wv); i0 < tot_; i0 += 4 * str_) {
        f32x4 v[4];
#pragma unroll
        for (int k = 0; k < 4; ++k) { const size_t i = i0 + k * str_ < tot_ ? i0 + k * str_ : i0, e = i * 4; v[k] = e < (size_t)MP * 256 ? *(const f32x4*)(pp + e) : *(const f32x4*)(ps + (e - (size_t)MP * 256)); }
#pragma unroll
        for (int k = 0; k < 4; ++k) { const size_t i = i0 + k * str_; if (i < tot_) { u32x2 w; w.x = pk2(v[k][0], v[k][1]); w.y = pk2(v[k][2], v[k][3]); *(u32x2*)(dst + i * 4) = w; } }
    }
}

__device__ __forceinline__ void phase2b(int wv, const Params& p, float* smem) {
    const int tid = opaque_tid(wv), lane = tid & 63, nb = gridDim.x, bid = blockIdx.x, gw = bid * 8 + (tid >> 6), nw = nb * 8;
    const bf16_t* Z = (const bf16_t*)(p.ws + WS_BIG); bf16_t* Mix = (bf16_t*)(p.ws + WS_Y); const float* ORAW = (const float*)(p.ws + WS_X);
    {
        const float no0 = p.in[I_NORMO][lane * 2], no1 = p.in[I_NORMO][lane * 2 + 1];
        float n0[8], n1[8]; unsigned nz[8];
        auto fetch = [&](int row) {
#pragma unroll
            for (int k = 0; k < 8; ++k) { const int r = row + (k >> 2), c = (k & 3) * 128 + lane * 2; const float* op = ORAW + (size_t)r * 512 + c; n0[k] = op[0]; n1[k] = op[1]; nz[k] = *(const unsigned*)(Z + (size_t)r * LDZ + 1536 + c); } };
        if (gw * 2 < MROWS) fetch(gw * 2);
        for (int row = gw * 2; row < MROWS; row += nw * 2) {
            float o0[8], o1[8]; unsigned zg[8];
#pragma unroll
            for (int k = 0; k < 8; ++k) { o0[k] = n0[k]; o1[k] = n1[k]; zg[k] = nz[k]; }
            if (row + nw * 2 < MROWS) fetch(row + nw * 2);
#pragma unroll
            for (int k = 0; k < 8; ++k) { const int r = row + (k >> 2), c = (k & 3) * 128 + lane * 2;
                const float rs = rsqrtf(wave_sum(o0[k] * o0[k] + o1[k] * o1[k]) * (1.0f / 128.0f) + EPSF);
                const float g0 = siluf_(__uint_as_float(zg[k] << 16)), g1 = siluf_(__uint_as_float(zg[k] & 0xffff0000u));
                *(unsigned*)(Mix + (size_t)r * 1024 + c) = pk2(o0[k] * rs * no0 * g0, o1[k] * rs * no1 * g1); }
        }
    }
    for (int i = bid * 512 + tid; i < 8 * 3 * 1536; i += nb * 512) { const int c = i % 1536, r = (i / 1536) % 3, b = i / (3 * 1536); p.out[O_CONV_P + i] = bf2f(Z[(size_t)(b * 2048 + 2045 + r) * LDZ + c]); }
    for (int i0 = bid * 512 + tid; i0 < 128 * 3 * 1536; i0 += 4 * nb * 512) { bf16_t v[4];
#pragma unroll
        for (int k = 0; k < 4; ++k) { const int i = i0 + k * nb * 512 < 128 * 3 * 1536 ? i0 + k * nb * 512 : i0, c = i % 1536, r = (i / 1536) % 3, b = i / (3 * 1536); v[k] = Z[(size_t)(MP + b * 8 + 5 + r) * LDZ + c]; }
#pragma unroll
        for (int k = 0; k < 4; ++k) { const int i = i0 + k * nb * 512; if (i < 128 * 3 * 1536) p.out[O_CONV_S + i] = bf2f(v[k]); } }
    for (int it = bid; it < 256; it += nb) sgu_prompt_item(wv, p, smem, it >> 5, (it >> 1) & 15, (it & 1) * 2);
    for (int it = bid; it < 128; it += nb) sgu_sample_item(wv, p, smem, it);
}

template <bool PROMPT>
__device__ __forceinline__ void s5_item(const Params& p, float* wl  , float* exch  , int wid, int b, int g) {
    constexpr bool sample = !PROMPT;
    const int lane = lane_id_(), lr16 = lane & 15, lq = lane >> 4;
    const float* Z1 = (const float*)(p.ws + WS_BIG + BIG_Z1); bf16_t* YG = (bf16_t*)(p.ws + WS_BIG + BIG_YG);
    float* buL = wl; float* sL = wl + 16 * 132;
    int row0 = sample ? MP + b * 8 : b * 2048;
    const float dt = __expf(p.in[I_LOGDT][g]);
    const float* lamre = p.in[I_LAMRE] + g * 64; const float* lamim = p.in[I_LAMIM] + g * 64;
    float lbr, lbi;
    { const float x = lamre[lane] * dt, y = lamim[lane] * dt, ex = __expf(x); float sn, cs; sincosf(y, &sn, &cs); lbr = ex * cs; lbi = ex * sn; }
    float sr = 0.f, si = 0.f;
    if (sample) { sr = p.in[I_S5RE][((size_t)b * 32 + g) * 64 + lane]; si = p.in[I_S5IM][((size_t)b * 32 + g) * 64 + lane]; }
    bf16x8 bfr[8];
    {
        float fre[4], fim[4];
#pragma unroll
        for (int j = 0; j < 4; ++j) { const int nn = j * 16 + lr16; const float lr = lamre[nn], li = lamim[nn], x = lr * dt, y = li * dt; float sn, cs; sincosf(y, &sn, &cs);
            const float ex = __expf(x), em = expm1f(x), sh = sinf(0.5f * y); const float re1 = em * cs - 2.f * sh * sh, im1 = ex * sn, den = 1.0f / (lr * lr + li * li);
            fre[j] = (re1 * lr + im1 * li) * den; fim[j] = (im1 * lr - re1 * li) * den; }
#pragma unroll
        for (int j = 0; j < 8; ++j) { const int nn = (j & 3) * 16 + lr16; const bool im = j >= 4; unsigned w[4] = {0u, 0u, 0u, 0u};
            if (lq < 2) { const float* br = p.in[I_BRE] + ((size_t)g * 64 + nn) * 16 + lq * 8; const float* bi = p.in[I_BIM] + ((size_t)g * 64 + nn) * 16 + lq * 8; float v[8];
#pragma unroll
                for (int i = 0; i < 8; ++i) v[i] = im ? (fre[j & 3] * bi[i] + fim[j & 3] * br[i]) : (fre[j & 3] * br[i] - fim[j & 3] * bi[i]);
#pragma unroll
                for (int i = 0; i < 4; ++i) w[i] = pk2(v[2 * i], v[2 * i + 1]); }
            bfr[j] = __builtin_bit_cast(bf16x8, (u32x4){w[0], w[1], w[2], w[3]}); }
    }
    bf16x8 cfr[4];
#pragma unroll
    for (int kk = 0; kk < 4; ++kk) { const int n0 = kk * 32 + lq * 8; const float* src = (n0 < 64 ? p.in[I_CRE] : p.in[I_CIM]) + ((size_t)g * 16 + lr16) * 64 + (n0 & 63); const float sg = n0 < 64 ? 1.f : -1.f; unsigned w[4];
#pragma unroll
        for (int i = 0; i < 4; ++i) w[i] = pk2(sg * src[2 * i], sg * src[2 * i + 1]);
        cfr[kk] = __builtin_bit_cast(bf16x8, (u32x4){w[0], w[1], w[2], w[3]}); }
    const float dsk = p.in[I_DSKIP][g * 16 + lr16];
    auto run = [&](const int t_lo, const int T, const bool yout) {
    f32x4 pa = {0.f, 0.f, 0.f, 0.f}, pc = {0.f, 0.f, 0.f, 0.f}; float pu[4] = {0.f, 0.f, 0.f, 0.f};
    auto fetch = [&](int t0) {
        const int nv = (T - t0) < 16 ? (T - t0) : 16;
        pa = (f32x4){0.f, 0.f, 0.f, 0.f}; pc = pa;
        if (lq < 2 && lr16 < nv) { const float* up = Z1 + (size_t)(row0 + t0 + lr16) * 1024 + 512 + g * 16 + lq * 8; pa = *(const f32x4*)up; pc = *(const f32x4*)(up + 4); }
#pragma unroll
        for (int jj = 0; jj < 4; ++jj) { const int tok = lq * 4 + jj; pu[jj] = tok < nv ? Z1[(size_t)(row0 + t0 + tok) * 1024 + 512 + g * 16 + lr16] : 0.f; }
    };
    fetch(t_lo);
    for (int t0 = t_lo; t0 < T; t0 += 16) {
        const int nv = (T - t0) < 16 ? (T - t0) : 16;
        const bf16x8 afr = __builtin_bit_cast(bf16x8, (u32x4){pk2(pa[0], pa[1]), pk2(pa[2], pa[3]), pk2(pc[0], pc[1]), pk2(pc[2], pc[3])});
        float ucur[4];
#pragma unroll
        for (int jj = 0; jj < 4; ++jj) ucur[jj] = pu[jj];
        if (t0 + 16 < T) fetch(t0 + 16);
#pragma unroll
        for (int j = 0; j < 8; ++j) { f32x4 acc = {0.f, 0.f, 0.f, 0.f}; acc = __builtin_amdgcn_mfma_f32_16x16x32_bf16(afr, bfr[j], acc, 0, 0, 0);
#pragma unroll
            for (int jj = 0; jj < 4; ++jj) buL[(lq * 4 + jj) * 132 + j * 16 + lr16] = acc[jj]; }
        asm volatile("s_waitcnt lgkmcnt(0)" ::: "memory");
        if (nv == 16) {
            float br_[16], bi_[16];
#pragma unroll
            for (int tt = 0; tt < 16; ++tt) { br_[tt] = buL[tt * 132 + lane]; bi_[tt] = buL[tt * 132 + 64 + lane]; }
#pragma unroll
            for (int tt = 0; tt < 16; ++tt) { const float nr = lbr * sr - lbi * si + br_[tt], ni = lbr * si + lbi * sr + bi_[tt]; sr = nr; si = ni;
                sL[tt * 132 + lane] = nr; sL[tt * 132 + 64 + lane] = ni; }
        } else {
            for (int tt = 0; tt < nv; ++tt) { const float bur = buL[tt * 132 + lane], bui = buL[tt * 132 + 64 + lane];
                const float nr = lbr * sr - lbi * si + bur, ni = lbr * si + lbi * sr + bui; sr = nr; si = ni;
                sL[tt * 132 + lane] = nr; sL[tt * 132 + 64 + lane] = ni; }
        }
        asm volatile("s_waitcnt lgkmcnt(0)" ::: "memory");
        if (!yout) continue;
        f32x4 yacc = {0.f, 0.f, 0.f, 0.f};
#pragma unroll
        for (int kk = 0; kk < 4; ++kk) { const float* sp = sL + lr16 * 132 + kk * 32 + lq * 8; const f32x4 a = *(const f32x4*)sp, c4 = *(const f32x4*)(sp + 4);
            const bf16x8 sfr = __builtin_bit_cast(bf16x8, (u32x4){pk2(a[0], a[1]), pk2(a[2], a[3]), pk2(c4[0], c4[1]), pk2(c4[2], c4[3])});
            yacc = __builtin_amdgcn_mfma_f32_16x16x32_bf16(sfr, cfr[kk], yacc, 0, 0, 0); }
#pragma unroll
        for (int jj = 0; jj < 4; ++jj) { const int tok = lq * 4 + jj;
            if (tok < nv) YG[(size_t)(row0 + t0 + tok) * 512 + g * 16 + lr16] = f2bf(geluf_(yacc[jj] + dsk * ucur[jj])); }
        asm volatile("s_waitcnt lgkmcnt(0)" ::: "memory");
    }
    };
    float* ore = p.out + (sample ? O_S5RE_S : O_S5RE_P) + ((size_t)b * 32 + g) * 64; float* oim = p.out + (sample ? O_S5IM_S : O_S5IM_P) + ((size_t)b * 32 + g) * 64;
    if (!PROMPT) {
        for (int bb = b; bb < 128; bb += 64) {
            row0 = MP + bb * 8; sr = p.in[I_S5RE][((size_t)bb * 32 + g) * 64 + lane]; si = p.in[I_S5IM][((size_t)bb * 32 + g) * 64 + lane];
            run(0, 8, true);
            p.out[O_S5RE_S + ((size_t)bb * 32 + g) * 64 + lane] = sr; p.out[O_S5IM_S + ((size_t)bb * 32 + g) * 64 + lane] = si; }
    }
    else {
        const int t_lo = wid * 256;
        run(t_lo, t_lo + 256, false);
        exch[wid * 128 + lane] = sr; exch[wid * 128 + 64 + lane] = si;
        __syncthreads();
        float pr = lbr, pi = lbi;
#pragma unroll
        for (int i = 0; i < 8; ++i) { const float nr = pr * pr - pi * pi, ni = 2.f * pr * pi; pr = nr; pi = ni; }
        float cr = 0.f, ci = 0.f;
        for (int j = 0; j < wid; ++j) { const float er = exch[j * 128 + lane], ei = exch[j * 128 + 64 + lane]; const float nr = pr * cr - pi * ci + er, ni = pr * ci + pi * cr + ei; cr = nr; ci = ni; }
        sr = cr; si = ci;
        run(t_lo, t_lo + 256, true);
        if (wid == 7) { ore[lane] = sr; oim[lane] = si; }
        __syncthreads();
    }
}

template <int WIN, int RB>
__device__ __forceinline__ void pool_item(const Params& p, const float* Z1, bf16_t* Mix, bool smp, int b, int t0, int rbase, int c) {
    constexpr int NR = WIN - 1 + RB;
    float x[NR];
#pragma unroll
    for (int r = 0; r < NR; ++r) { const int tp = t0 - (WIN - 1) + r;
        const float* src = tp >= 0 ? Z1 + (size_t)(rbase + tp) * 1024 + c : (smp ? p.in[I_SPOOL] + ((size_t)b * 15 + 15 + tp) * 512 + c : Z1 + (size_t)rbase * 1024 + c);
        const float v = *src; x[r] = (tp >= 0 || smp) ? v : 0.f; }
    float run = 0.f;
#pragma unroll
    for (int r = 0; r < WIN - 1; ++r) run += x[r];
#pragma unroll
    for (int j = 0; j < RB; ++j) { run += x[WIN - 1 + j]; const int t = t0 + j; const float cnt = smp ? (float)WIN : (float)((t + 1) < WIN ? (t + 1) : WIN);
        Mix[(size_t)(rbase + t) * 1024 + c] = f2bf(run / cnt - x[WIN - 1 + j]); run -= x[j]; }
}

__device__ __forceinline__ void pool_work(const Params& p, int lane, int hw, int nh) {
    const float* Z1 = (const float*)(p.ws + WS_BIG + BIG_Z1); bf16_t* Mix = (bf16_t*)(p.ws + WS_Y);
    for (int it = hw; it < 1024 * 8; it += nh) { const int blk = it >> 3, ck = it & 7, c = ck * 64 + lane, gi = ck >> 1, b = blk >> 7, t0 = (blk & 127) * 16, rbase = b * 2048;
        if (gi == 0) pool_item<2, 16>(p, Z1, Mix, false, b, t0, rbase, c); else if (gi == 1) pool_item<4, 16>(p, Z1, Mix, false, b, t0, rbase, c);
        else if (gi == 2) pool_item<8, 16>(p, Z1, Mix, false, b, t0, rbase, c); else pool_item<16, 16>(p, Z1, Mix, false, b, t0, rbase, c); }
    for (int it = hw; it < 128 * 8; it += nh) { const int b = it >> 3, ck = it & 7, c = ck * 64 + lane, gi = ck >> 1, rbase = MP + b * 8;
        if (gi == 0) pool_item<2, 8>(p, Z1, Mix, true, b, 0, rbase, c); else if (gi == 1) pool_item<4, 8>(p, Z1, Mix, true, b, 0, rbase, c);
        else if (gi == 2) pool_item<8, 8>(p, Z1, Mix, true, b, 0, rbase, c); else pool_item<16, 8>(p, Z1, Mix, true, b, 0, rbase, c); }
    for (int i = hw * 64 + lane; i < 8 * 15 * 512; i += nh * 64) { const int c = i & 511, r = (i >> 9) % 15, b = i / (15 * 512); p.out[O_POOL_P + i] = Z1[(size_t)(b * 2048 + 2033 + r) * 1024 + c]; }
    for (int i = hw * 64 + lane; i < 128 * 15 * 512; i += nh * 64) { const int c = i & 511, r = (i >> 9) % 15, b = i / (15 * 512);
        p.out[O_POOL_S + i] = r < 7 ? p.in[I_SPOOL][((size_t)b * 15 + r + 8) * 512 + c] : Z1[(size_t)(MP + b * 8 + r - 7) * 1024 + c]; }
}

__device__ __forceinline__ void phase8a(int wv, const Params& p, float* smem, bool pool_in_glu) {
    const int tid = opaque_tid(wv), lane = tid & 63, wid = __builtin_amdgcn_readfirstlane(tid >> 6), nb = gridDim.x, bid = blockIdx.x;
    float* wl = smem + wid * (2 * 16 * 132);
    const float* Z1 = (const float*)(p.ws + WS_BIG + BIG_Z1); bf16_t* Mix = (bf16_t*)(p.ws + WS_Y);
    float* exch = smem + 8 * (2 * 16 * 132);
    for (int it = bid; it < 256; it += nb) s5_item<true>(p, wl, exch, wid, it >> 5, it & 31);
    const int hw = bid * 8 + wid, nh = nb * 8;
    for (int it = hw; it < 2048; it += nh) s5_item<false>(p, wl, exch, wid, it >> 5, it & 31);
    if (!pool_in_glu) pool_work(p, lane, hw, nh);
}

#define XB_TMO      128
#define XB_XCNT(j)  (256  + 64 * (j))
#define XB_XSUB(j)  (1280 + 64 * (j))
#define XB_XGEN(j)  (2304 + 64 * (j))
#define XB_TOP      3328
#define XB_TOPGEN   3392
#define XB_SPIN_CAP (1u << 22)
__device__ __forceinline__ unsigned xb_ld(unsigned* p)              { return __hip_atomic_load(p, __ATOMIC_RELAXED, __HIP_MEMORY_SCOPE_AGENT); }
__device__ __forceinline__ unsigned xb_add(unsigned* p, unsigned v) { return __hip_atomic_fetch_add(p, v, __ATOMIC_RELAXED, __HIP_MEMORY_SCOPE_AGENT); }
__device__ __forceinline__ unsigned xb_xcc_id() { return (unsigned)__builtin_amdgcn_s_getreg((3 << 11) | 20) & 0xFu; }
#define XB_SPIN(cond, bar) do { unsigned _sp = 0; while (cond) { __builtin_amdgcn_s_sleep(1); \
    if ((++_sp & 255u) == 0u) { if (xb_ld(&(bar)[XB_TMO])) break; if (_sp > XB_SPIN_CAP) { atomicAdd(&(bar)[XB_TMO], 1u); break; } } } } while (0)
__device__ __forceinline__ void xcd_barrier_complete(unsigned* bar, unsigned x, unsigned& nloc, unsigned& nx) {
    const unsigned G = gridDim.x;
    unsigned sum, cnt, mine, sp = 0u;
    for (;;) {
        sum = 0u; cnt = 0u; mine = 0u;
#pragma unroll
        for (unsigned j = 0; j < 16; ++j) { const unsigned c = xb_ld(&bar[XB_XCNT(j)]); sum += c; cnt += (c > 0u) ? 1u : 0u; mine = (j == x) ? c : mine; }
        if (sum == G) break;
        __builtin_amdgcn_s_sleep(1);
        if ((++sp & 255u) == 0u) { if (xb_ld(&bar[XB_TMO])) break; if (sp > XB_SPIN_CAP) { atomicAdd(&bar[XB_TMO], 1u); break; } }
    }
    nloc = mine > 0u ? mine : 1u; nx = cnt > 0u ? cnt : 1u;
}
__device__ __forceinline__ void grid_bar(unsigned* bar, volatile PG8_LAS unsigned* st) {
    asm volatile("s_waitcnt vmcnt(0) lgkmcnt(0)" ::: "memory");
    __syncthreads();
    if (threadIdx.x == 0) {
        const unsigned x = xb_xcc_id();
        unsigned nloc = st[0], nx = st[1];
        if (nloc == 0u) { xcd_barrier_complete(bar, x, nloc, nx); st[0] = nloc; st[1] = nx; }
        const unsigned old = xb_add(&bar[XB_XSUB(x)], 1u);
        const unsigned gen = old / nloc;
        if (old + 1u == (gen + 1u) * nloc) {
            __builtin_amdgcn_fence(__ATOMIC_RELEASE, "agent");
            asm volatile("s_waitcnt vmcnt(0)" ::: "memory");
            const unsigned og = xb_add(&bar[XB_TOP], 1u);
            const unsigned tg = og / nx;
            if (og + 1u == (tg + 1u) * nx) xb_add(&bar[XB_TOPGEN], 1u);
            else XB_SPIN(xb_ld(&bar[XB_TOPGEN]) == tg, bar);
            __builtin_amdgcn_fence(__ATOMIC_ACQUIRE, "agent");
            xb_add(&bar[XB_XGEN(x)], 1u);
            asm volatile("s_waitcnt vmcnt(0)" ::: "memory");
        } else {
            XB_SPIN(xb_ld(&bar[XB_XGEN(x)]) == gen, bar);
            __builtin_amdgcn_fence(__ATOMIC_ACQUIRE, "agent");
            asm volatile("s_waitcnt vmcnt(0)" ::: "memory");
        }
    }
    __syncthreads();
}
#ifndef PROBE_GROUP
#define PROBE_GROUP 0
#endif
#define TB(g) do { if (PROBE_GROUP == (g)) t0_ = __builtin_amdgcn_s_memrealtime(); } while (0)
#define TE(g) do { if (PROBE_GROUP == (g)) tacc_ += __builtin_amdgcn_s_memrealtime() - t0_; } while (0)
__global__ void __launch_bounds__(512) fwd_megakernel(Params p) {
    extern __shared__ __attribute__((aligned(16))) unsigned char dynlds[];
    cg::grid_group grid = cg::this_grid();
    PG8_LAS unsigned char* lds = (PG8_LAS unsigned char*)dynlds;
    float* smem = (float*)dynlds;
    unsigned char* ws = p.ws;
    bf16_t* WB = (bf16_t*)(ws + WS_WB); bf16_t* X = (bf16_t*)(ws + WS_X); bf16_t* Y = (bf16_t*)(ws + WS_Y); float* ss = (float*)(ws + WS_SS);
    bf16_t* BIGb = (bf16_t*)(ws + WS_BIG);
    float* H = p.out + O_Y;

    const int wv = __builtin_amdgcn_readfirstlane((int)threadIdx.x >> 6);
    unsigned long long t0_ = 0, tacc_ = 0;
    const bool pool_in_glu = gridDim.x >= 200u;
    unsigned* gbar = (unsigned*)(ws + WS_BAR); volatile PG8_LAS unsigned* xbst = (volatile PG8_LAS unsigned*)(lds + LDS_XB);
    if (threadIdx.x == 0) { xbst[0] = 0u; xbst[1] = 0u; (void)xb_add(&gbar[XB_XCNT(xb_xcc_id())], 1u); }
#define GSYNC() grid_bar(gbar, xbst)
    if (p.out == nullptr) grid.sync();
    TB(1); phase0(wv, p, smem);
    GSYNC(); TE(1);
    TB(5);
    run_gemm(wv, lds, X, WB + WO_IN_AB, MROWS, LDZ, 1024, EpiZ{BIGb, LDZ, ss});
    for (;;) {
        volatile PG8_LAS unsigned* shw = (volatile PG8_LAS unsigned*)(lds + LDS_XB + 16);
        __syncthreads();
        if (threadIdx.x == 0) *shw = xb_add(&gbar[3500], 1u);
        __syncthreads();
        const unsigned vb = *shw;
        if (vb >= 1024u) break;
        convert_rest(wv, p, smem, (int)vb, 1024);
    }
    GSYNC(); TE(5);
    TB(2); phase2p(wv, p, smem);
    GSYNC();
    phase2a(wv, p, smem);
    GSYNC(); TE(2);
    TB(3); phase2b(wv, p, smem);
    GSYNC(); TE(3);
    TB(6);
    { const QResF q{p.in[I_XP], p.in[I_XS], X}; run_gemm(wv, lds, Y, WB + WO_OUT_AB, MP, 1024, 1024, EpiQ<QResF, true>{q, ss + 1 * MROWS});
      tail_gemm<QResF, true>(wv, dynlds, Y + (size_t)MP * 1024, 1024, WB + WO_OUT_AB, 1024, 1024, q, ss + 1 * MROWS); }
    GSYNC(); TE(6);
    TB(7);
    { const QUp q{BIGb, ss + 1 * MROWS}; run_gemm(wv, lds, X, WB + WO_UP0, MP, DFF, 1024, EpiQ<QUp, false>{q, nullptr});
      tail_gemm<QUp, false, 2>(wv, dynlds, X + (size_t)MP * 1024, 1024, WB + WO_UP0, DFF, 1024, q, nullptr); }
    GSYNC(); TE(7);
    TB(8);
    { const QResB q{X, Y}; run_gemm(wv, lds, BIGb, WB + WO_DOWN0, MP, 1024, DFF, EpiQ<QResB, true>{q, ss + 2 * MROWS});
      tail_gemm<QResB, true>(wv, dynlds, BIGb + (size_t)MP * DFF, DFF, WB + WO_DOWN0, 1024, DFF, q, ss + 2 * MROWS); }
    convert_p(wv, p, 0, WB + WO_IN_AB, (int)blockIdx.x, (int)gridDim.x);
    GSYNC(); TE(8);
    TB(9);
    { const QGate qg{BIGb, ss + 2 * MROWS}; const QProj qp{BIGb, Y, X};
      run_gemm(wv, lds, Y, WB + WO_GATE0, MP, 1024, 1024, EpiQ<QGate, false>{qg, nullptr});
      tail_gemm<QGate, false>(wv, dynlds, Y + (size_t)MP * 1024, 1024, WB + WO_GATE0, 1024, 1024, qg, nullptr);
      asm volatile("s_waitcnt vmcnt(0)" ::: "memory"); __syncthreads();
      run_gemm(wv, lds, WB + WO_IN_AB, WB + WO_PROJ0, MP, 1024, 256, EpiQ<QProj, true>{qp, ss + 3 * MROWS});
      tail_gemm<QProj, true>(wv, dynlds, WB + WO_IN_AB + (size_t)MP * 256, 256, WB + WO_PROJ0, 1024, 256, qp, ss + 3 * MROWS); }
    GSYNC(); TE(9);
    TB(10);
    { const QZ1 q{(float*)(ws + WS_BIG + BIG_Z1), ss + 3 * MROWS}; run_gemm(wv, lds, X, WB + WO_IN_CD, MP, 1024, 1024, EpiQ<QZ1, false>{q, nullptr});
      tail_gemm<QZ1, false>(wv, dynlds, X + (size_t)MP * 1024, 1024, WB + WO_IN_CD, 1024, 1024, q, nullptr); }
    GSYNC(); TE(10);
    TB(4); phase8a(wv, p, smem, pool_in_glu);
    GSYNC(); TE(4);
    TB(11);
    run_gemm(wv, lds, (const bf16_t*)(ws + WS_BIG + BIG_YG), WB + WO_GLU, MROWS, 512, 512, EpiGlu{(const bf16_t*)(ws + WS_BIG + BIG_YG), p.in[I_BGLU], Y});
    if (pool_in_glu && (int)blockIdx.x >= 136) {
        const int ib = (int)blockIdx.x - 136, nib = (int)gridDim.x - 136, tidg = opaque_tid(wv);
        pool_work(p, tidg & 63, ib * 8 + (tidg >> 6), nib * 8);
        convert_p(wv, p, 1, WB + WO_UP0, ib, nib);
    }
    GSYNC(); TE(11);
    TB(6);
    { const QResB q{X, X}; run_gemm(wv, lds, Y, WB + WO_OUT_CD, MP, 1024, 1024, EpiQ<QResB, true>{q, ss + 4 * MROWS});
      tail_gemm<QResB, true>(wv, dynlds, Y + (size_t)MP * 1024, 1024, WB + WO_OUT_CD, 1024, 1024, q, ss + 4 * MROWS); }
    GSYNC(); TE(6);
    TB(7);
    { const QUp q{BIGb, ss + 4 * MROWS}; run_gemm(wv, lds, X, WB + WO_UP1, MP, DFF, 1024, EpiQ<QUp, false>{q, nullptr});
      tail_gemm<QUp, false, 2>(wv, dynlds, X + (size_t)MP * 1024, 1024, WB + WO_UP1, DFF, 1024, q, nullptr); }
    GSYNC(); TE(7);
    TB(8);
    { const QResB q{X, Y}; run_gemm(wv, lds, BIGb, WB + WO_DOWN1, MP, 1024, DFF, EpiQ<QResB, true>{q, ss + 5 * MROWS});
      tail_gemm<QResB, true>(wv, dynlds, BIGb + (size_t)MP * DFF, DFF, WB + WO_DOWN1, 1024, DFF, q, ss + 5 * MROWS); }
    if (!pool_in_glu) convert_p(wv, p, 1, WB + WO_UP0, (int)blockIdx.x, (int)gridDim.x);
    GSYNC(); TE(8);
    TB(9);
    { const QGate qg{BIGb, ss + 5 * MROWS}; const QProj qp{BIGb, Y, X};
      run_gemm(wv, lds, Y, WB + WO_GATE1, MP, 1024, 1024, EpiQ<QGate, false>{qg, nullptr});
      tail_gemm<QGate, false>(wv, dynlds, Y + (size_t)MP * 1024, 1024, WB + WO_GATE1, 1024, 1024, qg, nullptr);
      asm volatile("s_waitcnt vmcnt(0)" ::: "memory"); __syncthreads();
      run_gemm(wv, lds, WB + WO_UP0, WB + WO_PROJ1, MP, 1024, 256, EpiQ<QProj, true>{qp, ss + 6 * MROWS});
      tail_gemm<QProj, true>(wv, dynlds, WB + WO_UP0 + (size_t)MP * 256, 256, WB + WO_PROJ1, 1024, 256, qp, ss + 6 * MROWS); }
    GSYNC(); TE(9);
    {
        const int tidf = opaque_tid(wv), lane = tidf & 63, gw = blockIdx.x * 8 + (tidf >> 6), nw = gridDim.x * 8; const float* gf = p.in[I_NFINAL]; const float* s6 = ss + 6 * MROWS;
        f32x4 gq[4];
#pragma unroll
        for (int i = 0; i < 4; ++i) gq[i] = *(const f32x4*)(gf + (i * 64 + lane) * 4);
        for (int rowa = gw; rowa < MROWS; rowa += 4 * nw) {
            u32x2 xv[4][4]; float rs[4];
#pragma unroll
            for (int k = 0; k < 4; ++k) { const int row = rowa + k * nw < MROWS ? rowa + k * nw : rowa; rs[k] = rstd_of(s6, row);
#pragma unroll
                for (int i = 0; i < 4; ++i) xv[k][i] = *(const u32x2*)(X + (size_t)row * 1024 + (i * 64 + lane) * 4); }
#pragma unroll
            for (int k = 0; k < 4; ++k) { const int row = rowa + k * nw;
                if (row < MROWS) {
#pragma unroll
                    for (int i = 0; i < 4; ++i) *(f32x4*)(H + (size_t)row * 1024 + (i * 64 + lane) * 4) = bf4_to_f(xv[k][i]) * rs[k] * gq[i]; } }
        }
    }
    if (PROBE_GROUP != 0 && blockIdx.x == 0) { const unsigned long long ts = __builtin_amdgcn_s_memrealtime(); while (__builtin_amdgcn_s_memrealtime() - ts < tacc_) __builtin_amdgcn_s_sleep(8); }
}

extern "C" void kernel_launch(void* const* d_in, const int* in_sizes, int n_in, void* d_out, int out_size, void* d_ws, size_t ws_size, hipStream_t stream) {
    static int grid_blocks = 0;
    if (grid_blocks == 0) {
        if (n_in != NIN || (size_t)out_size != O_END || ws_size < WS_END) { fprintf(stderr, "kernel_launch: unexpected shapes n_in %d out %d ws %zu\n", n_in, out_size, ws_size); grid_blocks = -1; return; }
        int dev = 0, cus = 0, per_cu = 0;
        hipGetDevice(&dev);
        hipDeviceGetAttribute(&cus, hipDeviceAttributeMultiprocessorCount, dev);
        if (hipFuncSetAttribute((const void*)fwd_megakernel, hipFuncAttributeMaxDynamicSharedMemorySize, LDS_BYTES) != hipSuccess) { fprintf(stderr, "kernel_launch: hipFuncSetAttribute failed\n"); grid_blocks = -1; return; }
        if (hipOccupancyMaxActiveBlocksPerMultiprocessor(&per_cu, (const void*)fwd_megakernel, 512, LDS_BYTES) != hipSuccess || per_cu < 1) { fprintf(stderr, "kernel_launch: occupancy query failed (%d)\n", per_cu); per_cu = 1; (void)hipGetLastError(); }
        grid_blocks = cus * per_cu;
    }
    if (grid_blocks < 0) return;
    Params p{};
    for (int i = 0; i < NIN; ++i) p.in[i] = (const float*)d_in[i];
    p.out = (float*)d_out; p.ws = (unsigned char*)d_ws;
    if (hipMemsetAsync((char*)d_ws + WS_BAR, 0, 16384, stream) != hipSuccess) { fprintf(stderr, "kernel_launch: memset of the barrier word failed\n"); return; }
    void* args[] = {&p};
    hipError_t e = hipLaunchCooperativeKernel((const void*)fwd_megakernel, dim3(grid_blocks), dim3(512), args, LDS_BYTES, stream);
    if (e != hipSuccess) fprintf(stderr, "cooperative launch failed: %s (grid %d)\n", hipGetErrorString(e), grid_blocks);
}
```
